# Optimizing an MI355X kernel written in HIP

```python
import jax, jax.numpy as jnp
from jax import lax
import numpy as np

D_MODEL = 1024
BATCH = 8
SEQ = 2048
DEPTH = 4

CHUNK = 64
N_MIXERS = 2
CONV_WIDTH = 31
POOL_WINDOWS = (2, 4, 8, 16)
N_POOL_GROUPS = len(POOL_WINDOWS)
GROUP_WIDTH = D_MODEL // N_POOL_GROUPS
D_FF = 4 * D_MODEL
N_CONV_LAYERS = (DEPTH + 1) // 2
N_POOL_LAYERS = DEPTH // 2
EPS = 1e-6

kernel_name = "hybrid_conv_pool_streaming_encoder"


def rmsnorm(x, g):
    xf = x.astype(jnp.float32)
    y = xf * lax.rsqrt(jnp.mean(xf * xf, axis=-1, keepdims=True) + EPS)
    return (y * g.astype(jnp.float32)).astype(x.dtype)


def layernorm(x, g, b):
    xf = x.astype(jnp.float32)
    mu = jnp.mean(xf, axis=-1, keepdims=True)
    var = jnp.mean(jnp.square(xf - mu), axis=-1, keepdims=True)
    y = (xf - mu) * lax.rsqrt(var + EPS)
    return (y * g.astype(jnp.float32) + b.astype(jnp.float32)).astype(x.dtype)


def conformer_conv(h, w1, b1, w_dw, b_dw, ln_g, ln_b, w2, b2):
    u = jnp.einsum('bsd,de->bse', h, w1) + b1
    a, gate = jnp.split(u, 2, axis=-1)
    u = a * jax.nn.sigmoid(gate)
    u = lax.conv_general_dilated(
        u, w_dw[:, None, :].astype(u.dtype),
        window_strides=(1,), padding=[(CONV_WIDTH - 1, 0)],
        dimension_numbers=('NWC', 'WIO', 'NWC'),
        feature_group_count=D_MODEL) + b_dw
    u = jax.nn.silu(layernorm(u, ln_g, ln_b))
    return jnp.einsum('bsd,de->bse', u, w2) + b2


def pool_mixer(h, w_grp, b_grp, scale):
    S = h.shape[1]
    hf = h.astype(jnp.float32)
    cs = jnp.concatenate([jnp.zeros_like(hf[:, :1]), jnp.cumsum(hf, axis=1)], axis=1)
    pos = jnp.arange(S)
    outs = []
    for g, w in enumerate(POOL_WINDOWS):
        sl = slice(g * GROUP_WIDTH, (g + 1) * GROUP_WIDTH)
        lo = jnp.maximum(pos + 1 - w, 0)
        cnt = (pos + 1 - lo).astype(jnp.float32)[None, :, None]
        mean = (cs[:, pos + 1, sl] - cs[:, lo, sl]) / cnt
        outs.append(mean - hf[..., sl])
    p = jnp.concatenate(outs, axis=-1).astype(h.dtype)
    p = p.reshape(p.shape[0], S, N_POOL_GROUPS, GROUP_WIDTH)
    y = jnp.einsum('bsgc,gcd->bsgd', p, w_grp) + b_grp
    return y.reshape(h.shape) * scale


def sqrelu_mlp(h, w1, w2):
    u = jax.nn.relu(jnp.einsum('bsd,df->bsf', h, w1))
    return jnp.einsum('bsf,fd->bsd', u * u, w2)


def setup_inputs(seed: int = 0) -> dict:
    key = jax.random.key(seed)
    ks = jax.random.split(key, 20)
    f = jnp.float32
    D, F, NC, NP, G, GW = D_MODEL, D_FF, N_CONV_LAYERS, N_POOL_LAYERS, N_POOL_GROUPS, GROUP_WIDTH
    nrm = lambda k, s, sc: jax.random.normal(k, s, f) * sc
    return {
        "x": jax.random.normal(ks[0], (BATCH, SEQ, D), f),
        "norm_mix": 1.0 + nrm(ks[1], (DEPTH, D), 0.05),
        "norm_mlp": 1.0 + nrm(ks[2], (DEPTH, D), 0.05),
        "conv_w1": nrm(ks[3], (NC, D, 2 * D), D ** -0.5),
        "conv_b1": nrm(ks[4], (NC, 2 * D), 0.02),
        "conv_dw": nrm(ks[5], (NC, CONV_WIDTH, D), CONV_WIDTH ** -0.5),
        "conv_dwb": nrm(ks[6], (NC, D), 0.02),
        "conv_ln_g": 1.0 + nrm(ks[7], (NC, D), 0.05),
        "conv_ln_b": nrm(ks[8], (NC, D), 0.02),
        "conv_w2": nrm(ks[9], (NC, D, D), D ** -0.5),
        "conv_b2": nrm(ks[10], (NC, D), 0.02),
        "pool_w": nrm(ks[11], (NP, G, GW, GW), GW ** -0.5),
        "pool_b": nrm(ks[12], (NP, G, GW), 0.02),
        "pool_scale": 1.0 + nrm(ks[13], (NP, D), 0.1),
        "mlp_w1": nrm(ks[14], (DEPTH, D, F), D ** -0.5),
        "mlp_w2": nrm(ks[15], (DEPTH, F, D), F ** -0.5),
        "final_norm": 1.0 + nrm(ks[16], (D,), 0.05),
    }


def reference(x, norm_mix, norm_mlp, conv_w1, conv_b1, conv_dw, conv_dwb,
              conv_ln_g, conv_ln_b, conv_w2, conv_b2, pool_w, pool_b,
              pool_scale, mlp_w1, mlp_w2, final_norm):
    h = x
    ic, ip = 0, 0
    for i in range(DEPTH):
        hn = rmsnorm(h, norm_mix[i])
        if i % N_MIXERS == 0:
            mix = conformer_conv(hn, conv_w1[ic], conv_b1[ic], conv_dw[ic], conv_dwb[ic],
                                 conv_ln_g[ic], conv_ln_b[ic], conv_w2[ic], conv_b2[ic])
            ic += 1
        else:
            mix = pool_mixer(hn, pool_w[ip], pool_b[ip], pool_scale[ip])
            ip += 1
        h = h + mix
        h = h + sqrelu_mlp(rmsnorm(h, norm_mlp[i]), mlp_w1[i], mlp_w2[i])
    return rmsnorm(h, final_norm)
```

```cpp
#include <hip/hip_runtime.h>
#include <cstdio>
#include <cstdint>
#include <type_traits>

#ifndef MK_PROBE
#define MK_PROBE 0
#endif
#ifndef MK_SHARE
#define MK_SHARE 0
#endif
#ifndef MK_EPI_DEPTH
#define MK_EPI_DEPTH 2
#endif
#ifndef MK_LDS2X
#define MK_LDS2X 0
#endif
#ifndef MK_EPI_OVL
#define MK_EPI_OVL 1
#endif
#ifndef MK_BAL
#define MK_BAL 1
#endif
#ifndef MK_PIPE
#define MK_PIPE 0
#endif
#ifndef MK_FUSE_POOL
#define MK_FUSE_POOL 1
#endif
#ifndef MK_PER_PHASE
#define MK_PER_PHASE 0
#endif

namespace pg8 {
#define PG8_LAS __attribute__((address_space(3)))
typedef unsigned short bf16_t;
typedef short bf16x8 __attribute__((ext_vector_type(8)));
typedef float f32x4 __attribute__((ext_vector_type(4)));
typedef unsigned u32x4 __attribute__((ext_vector_type(4)));
typedef unsigned u32x2 __attribute__((ext_vector_type(2)));
constexpr int BM = 256, BK = 64, HALF = 128, HTB = HALF * BK * 2  , STAGE_BYTES = 8 * HTB, NXCD = 8, WGM = 8;

__host__ __device__ __forceinline__ int lds_byte(int r, int c) { const int st = (r >> 4) * 2 + (c >> 5), rr = r & 15, cc = c & 31, ob = rr * 64 + cc * 2; return st * 1024 + (ob ^ (((ob >> 9) & 1) << 5)); }
__host__ __device__ __forceinline__ void stage_rc(int b, int& R, int& C) { const int st = b / 1024, sb = b % 1024, swz = sb ^ (((sb >> 9) & 1) << 5); R = (st >> 1) * 16 + swz / 64; C = (st & 1) * 32 + (swz % 64) / 2; }
__host__ __device__ __forceinline__ int perm32(int rho) { const int n = rho >> 4, i = rho & 15; return 8 * (i >> 2) + 4 * n + (i & 3); }

__device__ __forceinline__ int lane_now() { unsigned z = 0u; asm volatile("" : "+v"(z)); return (int)__builtin_amdgcn_mbcnt_hi(~0u, __builtin_amdgcn_mbcnt_lo(~0u, z)); }
struct Unit { int pm, pn; };
struct Gemm { const bf16_t* A; const bf16_t* Bt; int M, N, K; size_t a_pn_stride, a_bstride; };

struct StaticOrder {
    int nM, nN, nwg, G, c;
    __host__ __device__ void init(int M, int N, int G_, int c_) { nM = M / BM; nN = N / BM; nwg = nM * nN; G = G_; c = c_; }
    __host__ __device__ bool next(int i, Unit& u) const {
        const long L = (long)i * G + c; if (L >= nwg) return false;
        int wgid = (int)L; { const int q = nwg / NXCD, r = nwg % NXCD, xcd = wgid % NXCD, off = wgid / NXCD; wgid = (xcd < r ? xcd * (q + 1) : r * (q + 1) + (xcd - r) * q) + off; }
        const int nig = WGM * nN, gid = wgid / nig, fm = gid * WGM, gsz = (nM - fm) < WGM ? (nM - fm) : WGM;
        u.pm = fm + ((wgid % nig) % gsz); u.pn = (wgid % nig) / gsz; return true;
    }
    __device__ __forceinline__ void a_ready(const Unit&) const {}
    __device__ __forceinline__ void done(const Unit&) const {}
    static constexpr bool TWICE = false;
};
struct TwiceOrder : StaticOrder {
    __host__ __device__ bool next(int i, Unit& u) const { return StaticOrder::next(i >> 1, u); }
    static constexpr bool TWICE = true;
};

__device__ __forceinline__ unsigned cvt_pk_bf16(float lo, float hi) { unsigned r; asm volatile("v_cvt_pk_bf16_f32 %0, %1, %2" : "=v"(r) : "v"(lo), "v"(hi)); return r; }
constexpr float RMS_EPS = 1e-6f;

__device__ __forceinline__ void rows_rstd(const float* ss, int pm, PG8_LAS float* tab, int wr, int fr, int t, bool rebuild, float (&rs)[2][4]) {
    if (rebuild) {
        const int row = t >> 1, hf = t & 1;
        const f32x4* p = (const f32x4*)(ss + ((size_t)pm * BM + row) * 16 + 8 * hf);
        const f32x4 a = p[0], b = p[1]; float s = ((a[0] + a[1]) + (a[2] + a[3])) + ((b[0] + b[1]) + (b[2] + b[3]));
        s += __shfl_xor(s, 1);
        if (hf == 0) tab[row] = rsqrtf(s * (1.0f / 1024.0f) + RMS_EPS);
        asm volatile("s_waitcnt lgkmcnt(0)" ::: "memory"); __builtin_amdgcn_s_barrier(); asm volatile("" ::: "memory");
    }
#pragma unroll
    for (int ai = 0; ai < 2; ++ai)
#pragma unroll
        for (int m = 0; m < 4; ++m) rs[ai][m] = tab[ai * HALF + wr * 64 + m * 16 + fr];
}


struct EpiGlu {
    static constexpr bool PERM = true, AFTER_DRAIN = false;
    bf16_t* U; const float* bias; const float* ss; PG8_LAS float* tab;
    __device__ __forceinline__ void operator()(const f32x4 (&acc)[2][2][4][2], const Unit& u, int wr, int wc, int fr, int fq, int tid, int& tab_pm) const {
        const int row0 = u.pm * BM + wr * 64 + fr, col0 = u.pn * HALF + wc * 32 + 8 * fq;
        float rs[2][4]; rows_rstd(ss, u.pm, tab, wr, fr, tid, tab_pm != u.pm, rs); tab_pm = u.pm;
        f32x4 ba[2], bg[2];
#pragma unroll
        for (int n = 0; n < 2; ++n) { ba[n] = *(const f32x4*)(bias + col0 + 4 * n); bg[n] = *(const f32x4*)(bias + 1024 + col0 + 4 * n); }
#pragma unroll
        for (int ai = 0; ai < 2; ++ai)
#pragma unroll
            for (int m = 0; m < 4; ++m) { const float r = rs[ai][m]; float o[8];
#pragma unroll
                for (int n = 0; n < 2; ++n)
#pragma unroll
                    for (int i = 0; i < 4; ++i) { const float a = acc[ai][0][m][n][i] * r + ba[n][i], g = acc[ai][1][m][n][i] * r + bg[n][i];
                        o[4 * n + i] = a * __builtin_amdgcn_rcpf(1.0f + __builtin_amdgcn_exp2f(g * -1.44269504089f)); }
                u32x4 w; w.x = cvt_pk_bf16(o[0], o[1]); w.y = cvt_pk_bf16(o[2], o[3]); w.z = cvt_pk_bf16(o[4], o[5]); w.w = cvt_pk_bf16(o[6], o[7]);
                { const int row = row0 + ai * HALF + m * 16; *(u32x4*)(U + (size_t)(row >> 11) * (16u << 19) + (size_t)(row & 2047) * 1024 + col0) = w; } }
    }
};
struct EpiRelu2 {
    static constexpr bool PERM = true, AFTER_DRAIN = false;
    bf16_t* T; int ldc; const float* ss; PG8_LAS float* tab;
    __device__ __forceinline__ void operator()(const f32x4 (&acc)[2][2][4][2], const Unit& u, int wr, int wc, int fr, int fq, int tid, int& tab_pm) const {
        const int row0 = u.pm * BM + wr * 64 + fr, col0 = u.pn * BM + wc * 32 + 8 * fq;
        float rs[2][4]; rows_rstd(ss, u.pm, tab, wr, fr, tid, tab_pm != u.pm, rs); tab_pm = u.pm;
#pragma unroll
        for (int ai = 0; ai < 2; ++ai)
#pragma unroll
            for (int m = 0; m < 4; ++m) { const float r = rs[ai][m]; bf16_t* rowp = T + (size_t)(row0 + ai * HALF + m * 16) * ldc + col0;
#pragma unroll
                for (int bj = 0; bj < 2; ++bj) { f32x4 v0 = acc[ai][bj][m][0] * r, v1 = acc[ai][bj][m][1] * r;
#pragma unroll
                    for (int i = 0; i < 4; ++i) { v0[i] = fmaxf(v0[i], 0.f); v1[i] = fmaxf(v1[i], 0.f); }
                    v0 = v0 * v0; v1 = v1 * v1;
                    u32x4 w; w.x = cvt_pk_bf16(v0[0], v0[1]); w.y = cvt_pk_bf16(v0[2], v0[3]); w.z = cvt_pk_bf16(v1[0], v1[1]); w.w = cvt_pk_bf16(v1[2], v1[3]);
                    *(u32x4*)(rowp + bj * HALF) = w; } }
    }
};
struct EpiRes {
    static constexpr bool PERM = true, AFTER_DRAIN = false;
    bf16_t* hb; const float* bias; const float* bscale; float* ss; const bf16_t* hin;
    __device__ __forceinline__ void operator()(const f32x4 (&acc)[2][2][4][2], const Unit& u, int wr, int wc, int fr, int fq, int tid, int& tab_pm) const {
        const int row0 = u.pm * BM + wr * 64 + fr, col0 = u.pn * BM + wc * 32 + 8 * fq;
        f32x4 bv[2][2] = {{{0.f, 0.f, 0.f, 0.f}, {0.f, 0.f, 0.f, 0.f}}, {{0.f, 0.f, 0.f, 0.f}, {0.f, 0.f, 0.f, 0.f}}};
        if (bias) {
            const float* bs = bscale ? bscale : bias;
            f32x4 b[2][2], c[2][2];
#pragma unroll
            for (int bj = 0; bj < 2; ++bj)
#pragma unroll
                for (int n = 0; n < 2; ++n) { b[bj][n] = *(const f32x4*)(bias + col0 + bj * HALF + 4 * n); c[bj][n] = *(const f32x4*)(bs + col0 + bj * HALF + 4 * n); }
#pragma unroll
            for (int bj = 0; bj < 2; ++bj)
#pragma unroll
                for (int n = 0; n < 2; ++n) bv[bj][n] = bscale ? b[bj][n] * c[bj][n] : b[bj][n];
        }
        constexpr int DEPTH = MK_EPI_DEPTH;
        u32x4 pre[8][2];
#pragma unroll
        for (int g = 0; g < DEPTH; ++g)
#pragma unroll
            for (int bj = 0; bj < 2; ++bj) pre[g][bj] = *(const u32x4*)(hin + (size_t)(row0 + (g >> 2) * HALF + (g & 3) * 16) * 1024 + col0 + bj * HALF);
#pragma unroll
        for (int g = 0; g < 8; ++g) { const int ai = g >> 2, m = g & 3; const int row = row0 + ai * HALF + m * 16; const size_t off = (size_t)row * 1024 + col0; float q = 0.f;
            if (g + DEPTH < 8) {
#pragma unroll
                for (int bj = 0; bj < 2; ++bj) pre[g + DEPTH][bj] = *(const u32x4*)(hin + (size_t)(row0 + ((g + DEPTH) >> 2) * HALF + ((g + DEPTH) & 3) * 16) * 1024 + col0 + bj * HALF); }
#pragma unroll
            for (int bj = 0; bj < 2; ++bj) { const u32x4 o = pre[g][bj];
                f32x4 v0 = {__uint_as_float(o.x << 16), __uint_as_float(o.x & 0xffff0000u), __uint_as_float(o.y << 16), __uint_as_float(o.y & 0xffff0000u)};
                f32x4 v1 = {__uint_as_float(o.z << 16), __uint_as_float(o.z & 0xffff0000u), __uint_as_float(o.w << 16), __uint_as_float(o.w & 0xffff0000u)};
                v0 = v0 + acc[ai][bj][m][0] + bv[bj][0]; v1 = v1 + acc[ai][bj][m][1] + bv[bj][1];
                u32x4 w; w.x = cvt_pk_bf16(v0[0], v0[1]); w.y = cvt_pk_bf16(v0[2], v0[3]); w.z = cvt_pk_bf16(v1[0], v1[1]); w.w = cvt_pk_bf16(v1[2], v1[3]);
                *(u32x4*)(hb + off + bj * HALF) = w;
                q += (v0[0] * v0[0] + v0[1] * v0[1]) + (v0[2] * v0[2] + v0[3] * v0[3]) + (v1[0] * v1[0] + v1[1] * v1[1]) + (v1[2] * v1[2] + v1[3] * v1[3]); }
            q += __shfl_xor(q, 16); q += __shfl_xor(q, 32);
            if (fq == 0) ss[(size_t)row * 16 + u.pn * 4 + wc] = q; }
    }
};

template <class Epi, class Sched, bool ALIGN_EPI = false, bool SP2 = false>
__device__ __forceinline__ void gemm_phase(PG8_LAS unsigned char* lds, const Gemm g, const Sched& S, const Epi& E, const int tid) {
    const int wid = __builtin_amdgcn_readfirstlane(tid >> 6), lane = tid & 63, wr = wid >> 2, wc = wid & 3, fr = lane & 15, fq = lane >> 4;
    const int K = g.K, nt = K / BK;
    unsigned voffA[2], voffB[2];
#pragma unroll
    for (int i = 0; i < 2; ++i) { int R, C; stage_rc(tid * 16 + i * 8192, R, C); const int Rb = Epi::PERM ? ((R & ~31) + perm32(R & 31)) : R;
        voffA[i] = (unsigned)(R * K + C) * 2u; voffB[i] = (unsigned)(Rb * K + C) * 2u; }
    const unsigned kstep = (unsigned)(BK * 2), hstep = (unsigned)(HALF * K * 2), tstep = 2 * hstep;
    const unsigned pstep = (unsigned)(32 * K * 2);
    const __amdgpu_buffer_rsrc_t srdA = __builtin_amdgcn_make_buffer_rsrc((void*)g.A, (short)0, 0x7fffffff, 0x00020000), srdB = __builtin_amdgcn_make_buffer_rsrc((void*)g.Bt, (short)0, 0x7fffffff, 0x00020000);
    const unsigned ldsw = (unsigned)wid * 1024u;
    const int aoff = lds_byte(wr * 64 + fr, fq * 8), boff = lds_byte(wc * 32 + fr, fq * 8);
#define PG8_SA(b, h) (((b) * 2 + (h)) * HTB)
#define PG8_SB(b, h) ((4 + (b) * 2 + (h)) * HTB)
#define PG8_STAGE(bufoff, srd, soff, voff) do { _Pragma("unroll") for (int _i = 0; _i < 2; ++_i) \
        __builtin_amdgcn_raw_ptr_buffer_load_lds(srd, (PG8_LAS unsigned*)(lds + (bufoff) + ldsw + _i * 8192), 16, (voff)[_i], (soff), 0, 0); } while (0)
#define PG8_LDA1(dst, b, h) do { _Pragma("unroll") for (int m = 0; m < 4; ++m) _Pragma("unroll") for (int k = 0; k < 2; ++k) dst[m][k] = *(const PG8_LAS bf16x8*)(lds + PG8_SA(b, h) + aoff + m * 2048 + k * 1024); } while (0)
#if MK_LDS2X
#define PG8_LDA(dst, b, h) do { PG8_LDA1(dst, b, h); _Pragma("unroll") for (int m = 0; m < 4; ++m) _Pragma("unroll") for (int k = 0; k < 2; ++k) asm volatile("" : "+v"(dst[m][k])); asm volatile("" ::: "memory"); PG8_LDA1(dst, b, h); } while (0)
#else
#define PG8_LDA(dst, b, h) PG8_LDA1(dst, b, h)
#endif
#define PG8_LDB(dst, b, h) do { _Pragma("unroll") for (int n = 0; n < 2; ++n) _Pragma("unroll") for (int k = 0; k < 2; ++k) dst[n][k] = *(const PG8_LAS bf16x8*)(lds + PG8_SB(b, h) + boff + n * 2048 + k * 1024); } while (0)
#define PG8_MMA(ai, bj, At, Bt) do { __builtin_amdgcn_s_setprio(1); _Pragma("unroll") for (int m = 0; m < 4; ++m) _Pragma("unroll") for (int n = 0; n < 2; ++n) _Pragma("unroll") for (int k = 0; k < 2; ++k) \
        acc[ai][bj][m][n] = __builtin_amdgcn_mfma_f32_16x16x32_bf16(Bt[n][k], At[m][k], acc[ai][bj][m][n], 0, 0, 0); __builtin_amdgcn_s_setprio(0); } while (0)
#define PG8_WAIT_V(n) asm volatile("s_waitcnt vmcnt(" #n ")" ::: "memory")
#define PG8_WAIT_L(n) asm volatile("s_waitcnt lgkmcnt(" #n ")" ::: "memory")
#define PG8_BAR __builtin_amdgcn_s_barrier()
#define PG8_SCHED __builtin_amdgcn_sched_barrier(0)
    Unit cur, nxt; int ui = 0, tab_pm = -1;
    if (!S.next(0, cur)) return;
    f32x4 acc[2][2][4][2];
#pragma unroll
    for (int a = 0; a < 2; ++a)
#pragma unroll
        for (int b = 0; b < 2; ++b)
#pragma unroll
            for (int m = 0; m < 4; ++m)
#pragma unroll
                for (int n = 0; n < 2; ++n) acc[a][b][m][n] = (f32x4){0.f, 0.f, 0.f, 0.f};
    constexpr bool PIPE = SP2 && (MK_PIPE != 0);
    bf16x8 At[4][2], B0[2][2], B1[2][2]; bf16x8 Au[PIPE ? 4 : 1][2];
#define PG8_STAGE4(b, pa, pb) do { PG8_STAGE(PG8_SB(b, 0), srdB, (pb), voffB); PG8_STAGE(PG8_SB(b, 1), srdB, (pb) + hstep, voffB); PG8_STAGE(PG8_SA(b, 0), srdA, (pa), voffA); PG8_STAGE(PG8_SA(b, 1), srdA, (pa) + hstep, voffA); } while (0)
    unsigned cA = (unsigned)(cur.pm >> 3) * (unsigned)g.a_bstride + (unsigned)(cur.pm & 7) * tstep + (unsigned)cur.pn * (unsigned)g.a_pn_stride, cB = (unsigned)cur.pn * tstep;
    S.a_ready(cur);
    if constexpr (PIPE) {
        PG8_STAGE4(0, cA, cB); PG8_STAGE4(1, cA + kstep, cB + kstep);
        PG8_WAIT_V(8); PG8_BAR;
    } else if constexpr (SP2) {
        PG8_STAGE(PG8_SB(0, 0), srdB, cB, voffB); PG8_STAGE(PG8_SB(0, 1), srdB, cB + hstep, voffB); PG8_STAGE(PG8_SA(0, 0), srdA, cA, voffA); PG8_STAGE(PG8_SA(0, 1), srdA, cA + hstep, voffA);
        if (wr == 1) PG8_BAR;
        PG8_WAIT_V(2); PG8_BAR;
        if constexpr (MK_BAL != 0) { PG8_STAGE(PG8_SB(1, 0), srdB, cB + kstep, voffB); PG8_STAGE(PG8_SB(1, 1), srdB, cB + hstep + kstep, voffB); PG8_WAIT_V(4); PG8_BAR; }
        else {
        PG8_STAGE(PG8_SB(1, 0), srdB, cB + kstep, voffB); PG8_STAGE(PG8_SA(1, 0), srdA, cA + kstep, voffA); PG8_STAGE(PG8_SB(1, 1), srdB, cB + hstep + kstep, voffB);
        PG8_WAIT_V(6); PG8_BAR; }
    } else {
        PG8_STAGE(PG8_SB(0, 0), srdB, cB, voffB); PG8_STAGE(PG8_SA(0, 0), srdA, cA, voffA); PG8_STAGE(PG8_SB(0, 1), srdB, cB + hstep, voffB); PG8_STAGE(PG8_SA(0, 1), srdA, cA + hstep, voffA);
        if (wr == 1) PG8_BAR;
        PG8_WAIT_V(4); PG8_BAR;
        PG8_STAGE(PG8_SB(1, 0), srdB, cB + kstep, voffB); PG8_STAGE(PG8_SA(1, 0), srdA, cA + kstep, voffA); PG8_STAGE(PG8_SB(1, 1), srdB, cB + hstep + kstep, voffB);
        PG8_WAIT_V(6); PG8_BAR;
    }
    for (;;) {
        const bool has_next = S.next(ui + 1, nxt);
        const unsigned nA = has_next ? (unsigned)(nxt.pm >> 3) * (unsigned)g.a_bstride + (unsigned)(nxt.pm & 7) * tstep + (unsigned)nxt.pn * (unsigned)g.a_pn_stride : cA, nB = has_next ? (unsigned)nxt.pn * tstep : cB;
        if constexpr (PIPE) { PG8_LDA(At, 0, 0); PG8_LDB(B0, 0, 0); PG8_LDB(B1, 0, 1); PG8_SCHED; }
#pragma clang loop unroll(disable)
        for (int t = 0; t < nt; t += 2) {
            const bool last = (t == nt - 2);
            const unsigned a1 = cA + (unsigned)(t + 1) * kstep;
            const unsigned a2 = last ? nA : cA + (unsigned)(t + 2) * kstep, b2 = last ? nB : cB + (unsigned)(t + 2) * kstep;
            const unsigned a3 = a2 + kstep, b3 = b2 + kstep;
            if (last && has_next) S.a_ready(nxt);
            if constexpr (PIPE) {
#define PG8_KT(b, pa, pb, rn) do { \
            PG8_LDA(Au, b, 1); PG8_SCHED; \
            PG8_MMA(0, 0, At, B0); PG8_SCHED; \
            PG8_WAIT_L(0); PG8_WAIT_V(0); PG8_BAR; PG8_SCHED; \
            if (wr == 0) { PG8_STAGE(PG8_SB(b, 0), srdB, (pb), voffB); PG8_STAGE(PG8_SB(b, 1), srdB, (pb) + hstep, voffB); } PG8_SCHED; \
            PG8_MMA(0, 1, At, B1); PG8_SCHED; \
            if (rn) PG8_LDA(At, (b) ^ 1, 0); \
            if (wr == 0) { PG8_STAGE(PG8_SA(b, 0), srdA, (pa), voffA); PG8_STAGE(PG8_SA(b, 1), srdA, (pa) + hstep, voffA); } else { PG8_STAGE(PG8_SB(b, 0), srdB, (pb), voffB); PG8_STAGE(PG8_SB(b, 1), srdB, (pb) + hstep, voffB); } PG8_SCHED; \
            PG8_MMA(1, 0, Au, B0); PG8_SCHED; \
            if (rn) PG8_LDB(B0, (b) ^ 1, 0); \
            if (wr == 1) { PG8_STAGE(PG8_SA(b, 0), srdA, (pa), voffA); PG8_STAGE(PG8_SA(b, 1), srdA, (pa) + hstep, voffA); } PG8_SCHED; \
            PG8_MMA(1, 1, Au, B1); PG8_SCHED; \
            if (rn) PG8_LDB(B1, (b) ^ 1, 1); PG8_SCHED; } while (0)
            PG8_KT(0, a2, b2, true);
            PG8_KT(1, a3, b3, !last);
#undef PG8_KT
            } else if constexpr (SP2 && MK_BAL != 0) {
            PG8_LDB(B0, 0, 0); PG8_LDB(B1, 0, 1); PG8_SCHED; PG8_LDA(At, 0, 0); PG8_STAGE(PG8_SA(1, 0), srdA, a1, voffA); PG8_STAGE(PG8_SA(1, 1), srdA, a1 + hstep, voffA);
            PG8_WAIT_V(8); PG8_WAIT_L(0); PG8_BAR; PG8_MMA(0, 0, At, B0); PG8_MMA(0, 1, At, B1); PG8_BAR; PG8_SCHED;
            PG8_LDA(At, 0, 1); PG8_STAGE(PG8_SB(0, 0), srdB, b2, voffB); PG8_STAGE(PG8_SB(0, 1), srdB, b2 + hstep, voffB);
            PG8_WAIT_V(6); PG8_WAIT_L(0); PG8_BAR; PG8_MMA(1, 0, At, B0); PG8_MMA(1, 1, At, B1); PG8_BAR; PG8_SCHED;
            PG8_LDB(B0, 1, 0); PG8_LDB(B1, 1, 1); PG8_SCHED; PG8_LDA(At, 1, 0); PG8_STAGE(PG8_SA(0, 0), srdA, a2, voffA); PG8_STAGE(PG8_SA(0, 1), srdA, a2 + hstep, voffA);
            PG8_WAIT_V(8); PG8_WAIT_L(0); PG8_BAR; PG8_MMA(0, 0, At, B0); PG8_MMA(0, 1, At, B1); PG8_BAR; PG8_SCHED;
            PG8_LDA(At, 1, 1); PG8_STAGE(PG8_SB(1, 0), srdB, b3, voffB); PG8_STAGE(PG8_SB(1, 1), srdB, b3 + hstep, voffB);
            PG8_WAIT_V(6); PG8_WAIT_L(0); PG8_BAR; PG8_MMA(1, 0, At, B0); PG8_MMA(1, 1, At, B1); PG8_BAR; PG8_SCHED;
            } else if constexpr (SP2) {
            const bool landed = MK_EPI_OVL && t == 0 && ui > 0;
            PG8_LDB(B0, 0, 0); PG8_LDB(B1, 0, 1); PG8_SCHED; PG8_LDA(At, 0, 0); PG8_STAGE(PG8_SA(1, 1), srdA, a1 + hstep, voffA);
            if (!landed) PG8_WAIT_V(8); PG8_WAIT_L(0); PG8_BAR; PG8_MMA(0, 0, At, B0); PG8_MMA(0, 1, At, B1); PG8_BAR; PG8_SCHED;
            PG8_LDA(At, 0, 1); PG8_STAGE(PG8_SB(0, 0), srdB, b2, voffB); PG8_STAGE(PG8_SB(0, 1), srdB, b2 + hstep, voffB); PG8_STAGE(PG8_SA(0, 0), srdA, a2, voffA);
            if (!landed) PG8_WAIT_V(8); PG8_WAIT_L(0); PG8_BAR; PG8_MMA(1, 0, At, B0); PG8_MMA(1, 1, At, B1); PG8_BAR; PG8_SCHED;
            PG8_LDB(B0, 1, 0); PG8_LDB(B1, 1, 1); PG8_SCHED; PG8_LDA(At, 1, 0); PG8_STAGE(PG8_SA(0, 1), srdA, a2 + hstep, voffA);
            if (!landed) PG8_WAIT_V(8); PG8_WAIT_L(0); PG8_BAR; PG8_MMA(0, 0, At, B0); PG8_MMA(0, 1, At, B1); PG8_BAR; PG8_SCHED;
            PG8_LDA(At, 1, 1); PG8_STAGE(PG8_SB(1, 0), srdB, b3, voffB); PG8_STAGE(PG8_SB(1, 1), srdB, b3 + hstep, voffB); PG8_STAGE(PG8_SA(1, 0), srdA, a3, voffA);
            PG8_WAIT_V(8); PG8_WAIT_L(0); PG8_BAR; PG8_MMA(1, 0, At, B0); PG8_MMA(1, 1, At, B1); PG8_BAR; PG8_SCHED;
            } else {
            PG8_LDB(B0, 0, 0); PG8_SCHED; PG8_LDA(At, 0, 0); PG8_STAGE(PG8_SA(1, 1), srdA, a1 + hstep, voffA);
            PG8_WAIT_L(8); PG8_BAR; PG8_WAIT_L(0); PG8_MMA(0, 0, At, B0); PG8_BAR; PG8_SCHED;
            PG8_LDB(B1, 0, 1); PG8_STAGE(PG8_SB(0, 0), srdB, b2, voffB);
            PG8_BAR; PG8_WAIT_L(0); PG8_MMA(0, 1, At, B1); PG8_BAR;
            PG8_LDA(At, 0, 1); PG8_STAGE(PG8_SA(0, 0), srdA, a2, voffA);
            PG8_BAR; PG8_WAIT_L(0); PG8_MMA(1, 0, At, B0); PG8_BAR; PG8_SCHED;
            PG8_STAGE(PG8_SB(0, 1), srdB, b2 + hstep, voffB);
            PG8_WAIT_V(6); PG8_BAR; PG8_MMA(1, 1, At, B1); PG8_BAR;
            PG8_LDB(B0, 1, 0); PG8_SCHED; PG8_LDA(At, 1, 0); PG8_STAGE(PG8_SA(0, 1), srdA, a2 + hstep, voffA);
            PG8_WAIT_L(8); PG8_BAR; PG8_WAIT_L(0); PG8_MMA(0, 0, At, B0); PG8_BAR; PG8_SCHED;
            PG8_LDB(B1, 1, 1); PG8_STAGE(PG8_SB(1, 0), srdB, b3, voffB);
            PG8_BAR; PG8_WAIT_L(0); PG8_MMA(0, 1, At, B1); PG8_BAR;
            PG8_LDA(At, 1, 1); PG8_STAGE(PG8_SA(1, 0), srdA, a3, voffA);
            PG8_BAR; PG8_WAIT_L(0); PG8_MMA(1, 0, At, B0); PG8_BAR; PG8_SCHED;
            PG8_STAGE(PG8_SB(1, 1), srdB, b3 + hstep, voffB);
            PG8_WAIT_V(6); PG8_BAR; PG8_MMA(1, 1, At, B1); PG8_BAR;
            }
        }
        if constexpr (ALIGN_EPI && !PIPE) { if (wr == 0) PG8_BAR; }
        if constexpr (SP2 && !PIPE && MK_EPI_OVL && MK_BAL == 0) { if (has_next) PG8_WAIT_V(0); }
        if constexpr (!Epi::AFTER_DRAIN) { if (!Sched::TWICE || (ui & 1)) { const int le = lane_now(); E(acc, cur, wr, wc, le & 15, le >> 4, wid * 64 + le, tab_pm); S.done(cur); } }
        if (!has_next) break;
#pragma unroll
        for (int a = 0; a < 2; ++a)
#pragma unroll
            for (int b = 0; b < 2; ++b)
#pragma unroll
                for (int m = 0; m < 4; ++m)
#pragma unroll
                    for (int n = 0; n < 2; ++n) acc[a][b][m][n] = (f32x4){0.f, 0.f, 0.f, 0.f};
        cur = nxt; cA = nA; cB = nB; ++ui;
        if constexpr (ALIGN_EPI && !PIPE) { if (wr == 1) PG8_BAR; }
    }
    PG8_WAIT_V(0);
    if constexpr (!ALIGN_EPI && !PIPE) { if (wr == 0) PG8_BAR; }
    PG8_BAR;
#undef PG8_SA
#undef PG8_SB
#undef PG8_STAGE
#undef PG8_STAGE4
#undef PG8_LDA
#undef PG8_LDA1
#undef PG8_LDB
#undef PG8_MMA
#undef PG8_WAIT_V
#undef PG8_WAIT_L
#undef PG8_BAR
#undef PG8_SCHED
}

struct PoolSrc { const bf16_t* hb; const float* ss; };
__device__ __forceinline__ void pool_issue(unsigned (&x)[31], const __amdgpu_buffer_rsrc_t srd, unsigned soff, unsigned loff, bool above_zero) {
#pragma unroll
    for (int i = 0; i < 31; ++i) { unsigned v = __builtin_amdgcn_raw_buffer_load_b32(srd, (int)loff, (int)(soff + (unsigned)i * 2048u), 0); if (i < 15 && above_zero) v = 0u; x[i] = v; }
}
template <int W> __device__ __forceinline__ void pool_finish(const unsigned (&x)[31], const PG8_LAS float* tabr, PG8_LAS unsigned char* alo, PG8_LAS unsigned char* ahi, int R0, unsigned azv) {
    asm volatile("" : "+v"(azv)); const bool az = azv != 0u;
    typedef float f32x2 __attribute__((ext_vector_type(2)));
    const PG8_LAS float* tr = tabr + 16 + R0 - (W - 1);
#define PGF_HN(i) ((f32x2){__uint_as_float(x[16 - W + (i)] << 16), __uint_as_float(x[16 - W + (i)] & 0xffff0000u)} * tr[(i)])
    f32x2 win[W];
    f32x2 S = {0.f, 0.f};
#pragma unroll
    for (int i = 0; i < W; ++i) { win[i] = PGF_HN(i); S += win[i]; }
#pragma unroll
    for (int r = 0; r < 16; ++r) { const float inv = (r + 1 < W && az) ? 1.0f / (float)(r + 1) : 1.0f / (float)W;
        const f32x2 p = S * inv - win[(W - 1 + r) % W];
        *(PG8_LAS unsigned*)((r < 8 ? alo : ahi) + (r & 7) * 64) = cvt_pk_bf16(p.x, p.y);
        if (r < 15) { const f32x2 nw = PGF_HN(W + r); S += nw - win[r % W]; win[r % W] = nw; } }
#undef PGF_HN
}
template <class Epi, class Sched>
__device__ __forceinline__ void pool_gemm_phase(PG8_LAS unsigned char* lds, const bf16_t* Bt, const PoolSrc ps, const Sched& S, const Epi& E, const int tid) {
    const int wid = __builtin_amdgcn_readfirstlane(tid >> 6), lane = tid & 63, wr = wid >> 2, wc = wid & 3, fr = lane & 15, fq = lane >> 4;
    constexpr int K = 256;
    unsigned voffB[2];
#pragma unroll
    for (int i = 0; i < 2; ++i) { int R, C; stage_rc(tid * 16 + i * 8192, R, C); const int Rb = (R & ~31) + perm32(R & 31); voffB[i] = (unsigned)(Rb * K + C) * 2u; }
    const unsigned kstep = (unsigned)(BK * 2), hstep = (unsigned)(HALF * K * 2), tstep = 2 * hstep;
    const unsigned ldsw = (unsigned)wid * 1024u;
    const int aoff = lds_byte(wr * 64 + fr, fq * 8), boff = lds_byte(wc * 32 + fr, fq * 8);
    PG8_LAS float* const tabr = (PG8_LAS float*)(lds + STAGE_BYTES + 2048);
#define PGF_SA(b, h) (((b) * 2 + (h)) * HTB)
#define PGF_SB(b, h) ((4 + (b) * 2 + (h)) * HTB)
#define PGF_STAGE(bufoff, soff) do { _Pragma("unroll") for (int _i = 0; _i < 2; ++_i) \
        __builtin_amdgcn_raw_ptr_buffer_load_lds(srdB, (PG8_LAS unsigned*)(lds + (bufoff) + ldsw + _i * 8192), 16, voffB[_i], (soff), 0, 0); } while (0)
    const __amdgpu_buffer_rsrc_t srdB = __builtin_amdgcn_make_buffer_rsrc((void*)Bt, (short)0, 0x7fffffff, 0x00020000);
    const __amdgpu_buffer_rsrc_t srdH = __builtin_amdgcn_make_buffer_rsrc((void*)(ps.hb - 16 * 1024), (short)0, 0x7fffffff, 0x00020000);
    const int cp = tid & 31, R0 = (tid >> 5) * 16;
    const int stA = ((R0 >> 4) & 7) * 2 + (cp >> 4), hA = R0 >> 7, cb = (cp & 15) * 4;
    Unit cur; f32x4 acc[2][2][4][2]; bf16x8 At[4][2], B0[2][2]; int tab_pm = -1;
#pragma unroll 1
    for (int ui = 0; S.next(ui, cur); ++ui) {
        const int g = cur.pn, P = cur.pm, sq = (P & 7) * 256; const bool zero_above = (P & 7) == 0;
        int tq = tid; asm volatile("" : "+v"(tq));
        const bool trow = tq < 272 && !(tq < 16 && zero_above);
        f32x4 p0 = {0.f, 0.f, 0.f, 0.f}, p1 = p0, p2 = p0, p3 = p0;
        if (trow) { const f32x4* p = (const f32x4*)(ps.ss + (size_t)(P * BM + tq - 16) * 16); p0 = p[0]; p1 = p[1]; p2 = p[2]; p3 = p[3]; }
        __builtin_amdgcn_sched_barrier(0);
        const unsigned cB = (unsigned)g * tstep;
        PGF_STAGE(PGF_SB(0, 0), cB); PGF_STAGE(PGF_SB(0, 1), cB + hstep);
        const unsigned ub0 = (unsigned)((P * BM + 1) * 2048 + g * 512);
        const unsigned loff = (unsigned)(R0 * 2048 + 4 * cp); const bool above_zero = zero_above && R0 == 0; const unsigned azv = above_zero ? 1u : 0u;
        unsigned x[31];
        pool_issue(x, srdH, ub0, loff, above_zero);
        __builtin_amdgcn_sched_barrier(0);
        if (tq < 272) { float r = 0.f;
            if (trow) { const float t = ((p0[0] + p0[1]) + (p0[2] + p0[3])) + ((p1[0] + p1[1]) + (p1[2] + p1[3])) + ((p2[0] + p2[1]) + (p2[2] + p2[3])) + ((p3[0] + p3[1]) + (p3[2] + p3[3]));
                r = rsqrtf(t * (1.0f / 1024.0f) + RMS_EPS); }
            tabr[tq] = r; }
        asm volatile("s_waitcnt lgkmcnt(0)" ::: "memory"); __builtin_amdgcn_s_barrier(); asm volatile("" ::: "memory");
#define PGF_FIN(bb) do { PG8_LAS unsigned char* ab = lds + PGF_SA((bb), hA) + stA * 1024; \
          PG8_LAS unsigned char* alo = ab + cb, * ahi = ab + 512 + (cb ^ 32);                        \
          if (g == 0) pool_finish<2>(x, tabr, alo, ahi, R0, azv); else if (g == 1) pool_finish<4>(x, tabr, alo, ahi, R0, azv); else if (g == 2) pool_finish<8>(x, tabr, alo, ahi, R0, azv); else pool_finish<16>(x, tabr, alo, ahi, R0, azv); } while (0)
#define PGF_MMA(bb) do { _Pragma("unroll") for (int ai = 0; ai < 2; ++ai) { \
                _Pragma("unroll") for (int m = 0; m < 4; ++m) _Pragma("unroll") for (int k = 0; k < 2; ++k) At[m][k] = *(const PG8_LAS bf16x8*)(lds + PGF_SA((bb), ai) + aoff + m * 2048 + k * 1024); \
                _Pragma("unroll") for (int bj = 0; bj < 2; ++bj) { \
                    _Pragma("unroll") for (int n = 0; n < 2; ++n) _Pragma("unroll") for (int k = 0; k < 2; ++k) B0[n][k] = *(const PG8_LAS bf16x8*)(lds + PGF_SB((bb), bj) + boff + n * 2048 + k * 1024); \
                    __builtin_amdgcn_s_setprio(1); \
                    _Pragma("unroll") for (int m = 0; m < 4; ++m) _Pragma("unroll") for (int n = 0; n < 2; ++n) _Pragma("unroll") for (int k = 0; k < 2; ++k) \
                        acc[ai][bj][m][n] = __builtin_amdgcn_mfma_f32_16x16x32_bf16(B0[n][k], At[m][k], acc[ai][bj][m][n], 0, 0, 0); \
                    __builtin_amdgcn_s_setprio(0); } } } while (0)
        PGF_FIN(0);
        if (wr == 1) pool_issue(x, srdH, ub0 + 128u, loff, above_zero);
        __builtin_amdgcn_sched_barrier(0);
#pragma unroll
        for (int a = 0; a < 2; ++a)
#pragma unroll
            for (int b = 0; b < 2; ++b)
#pragma unroll
                for (int m = 0; m < 4; ++m)
#pragma unroll
                    for (int n = 0; n < 2; ++n) acc[a][b][m][n] = (f32x4){0.f, 0.f, 0.f, 0.f};
#pragma unroll 1
        for (int kt = 0; kt < 4; ++kt) { const int b = kt & 1;
            asm volatile("s_waitcnt lgkmcnt(0)" ::: "memory"); if (wr == 0 || kt == 3) asm volatile("s_waitcnt vmcnt(0)" ::: "memory"); else asm volatile("s_waitcnt vmcnt(31)" ::: "memory");
            __builtin_amdgcn_s_barrier(); asm volatile("" ::: "memory");
            if (kt < 3) { PGF_STAGE(PGF_SB(b ^ 1, 0), cB + (unsigned)(kt + 1) * kstep); PGF_STAGE(PGF_SB(b ^ 1, 1), cB + hstep + (unsigned)(kt + 1) * kstep); }
            if (wr == 1 && kt < 3) PGF_FIN(b ^ 1);
            if (kt + wr < 3) pool_issue(x, srdH, ub0 + 128u * (unsigned)(kt + 1 + wr), loff, above_zero);
            __builtin_amdgcn_sched_barrier(0);
            PGF_MMA(b);
            __builtin_amdgcn_sched_barrier(0);
            if (wr == 0 && kt < 3) PGF_FIN(b ^ 1);
        }
#undef PGF_FIN
#undef PGF_MMA
        { const int le = lane_now(); E(acc, cur, wr, wc, le & 15, le >> 4, wid * 64 + le, tab_pm); }
        asm volatile("s_waitcnt vmcnt(0) lgkmcnt(0)" ::: "memory"); __builtin_amdgcn_s_barrier(); asm volatile("" ::: "memory");
    }
#undef PGF_SA
#undef PGF_SB
#undef PGF_STAGE
}
}

constexpr int NWAVES = 8;
constexpr int BATCH = 8, SEQ = 2048, D = 1024, FF = 4096, DEPTH = 4, CW = 31, NG = 4, GW = 256;
constexpr int M = BATCH * SEQ;
constexpr float LN_EPS = 1e-6f;

constexpr size_t MiB = 1u << 20;
constexpr size_t WS_CTL = 0, CTL_ZERO_BYTES = 64 * 1024;
constexpr size_t WS_SS = 1 * MiB;
constexpr size_t WS_WC1 = 10 * MiB;
constexpr size_t WS_WC2 = 18 * MiB;
constexpr size_t WS_WP = 22 * MiB;
constexpr size_t WS_WM1 = 23 * MiB;
constexpr size_t WS_WM2 = 55 * MiB;
constexpr size_t WS_HB = 87 * MiB;
constexpr size_t WS_T = 119 * MiB;
constexpr size_t SLAB = 16 * MiB;
constexpr size_t WS_U = WS_T, WS_V = WS_T + 4 * MiB, WS_P = WS_T + 8 * MiB;
constexpr size_t WS_END = 247 * MiB;
constexpr size_t OUT_HB2 = 64 * 1024;
constexpr int CW_BAR = 1024;

constexpr int RING_OFF = 0, RING_BYTES = 131072;
constexpr int LDSCTL_OFF = RING_BYTES, MISC_OFF = LDSCTL_OFF + 320;
constexpr int LDS_BYTES = 147456;

#define GAS __attribute__((address_space(1)))
#define LAS __attribute__((address_space(3)))
typedef unsigned short bf16;
typedef unsigned v4u __attribute__((ext_vector_type(4)));
typedef unsigned v2u __attribute__((ext_vector_type(2)));
typedef float f32x4 __attribute__((ext_vector_type(4)));
typedef GAS unsigned gu32;
#define RLX_AGENT __ATOMIC_RELAXED, __HIP_MEMORY_SCOPE_AGENT
#define LDS_WAIT() asm volatile("s_waitcnt lgkmcnt(0)" ::: "memory")
#define VM_WAIT() asm volatile("s_waitcnt vmcnt(0)" ::: "memory")
__device__ __forceinline__ unsigned pk2(float lo, float hi) { return pg8::cvt_pk_bf16(lo, hi); }
__device__ __forceinline__ float bflo(unsigned u) { return __uint_as_float(u << 16); }
__device__ __forceinline__ float bfhi(unsigned u) { return __uint_as_float(u & 0xffff0000u); }

#define XB_TMO      128
#define XB_XCNT(j)  (256  + 64 * (j))
#define XB_XSUB(j)  (1280 + 64 * (j))
#define XB_XGEN(j)  (2304 + 64 * (j))
#define XB_TOP      3328
#define XB_TOPGEN   3392
#define XCD_BAR_WORDS 3456
#define XB_SPIN_CAP (1u << 18)
__device__ __forceinline__ unsigned xb_ld(unsigned* p)              { return __hip_atomic_load(p, __ATOMIC_RELAXED, __HIP_MEMORY_SCOPE_AGENT); }
__device__ __forceinline__ unsigned xb_add(unsigned* p, unsigned v) { return __hip_atomic_fetch_add(p, v, __ATOMIC_RELAXED, __HIP_MEMORY_SCOPE_AGENT); }
__device__ __forceinline__ unsigned xb_xcc_id() { return (unsigned)__builtin_amdgcn_s_getreg((3 << 11) | 20) & 0xFu; }
#define XB_SPIN(cond, bar) do { unsigned _sp = 0; while (cond) { __builtin_amdgcn_s_sleep(1); \
    if ((++_sp & 255u) == 0u) { if (xb_ld(&(bar)[XB_TMO])) break; if (_sp > XB_SPIN_CAP) { atomicAdd(&(bar)[XB_TMO], 1u); break; } } } } while (0)
struct XcdBarrier { unsigned* bar; unsigned x; volatile LAS unsigned* st; };
__device__ __forceinline__ XcdBarrier xcd_barrier_post(unsigned* bar, volatile LAS unsigned* st) {
    XcdBarrier b; b.bar = bar; b.x = xb_xcc_id(); b.st = st;
    if (threadIdx.x == 0) (void)xb_add(&bar[XB_XCNT(b.x)], 1u);
    return b;
}
__device__ __forceinline__ void xcd_barrier_complete(unsigned* bar, unsigned x, unsigned& nloc, unsigned& nx) {
    const unsigned G = gridDim.x * gridDim.y * gridDim.z;
    unsigned sum, cnt, mine, sp = 0u;
    for (;;) {
        sum = 0u; cnt = 0u; mine = 0u;
#pragma unroll
        for (unsigned j = 0; j < 16; ++j) { const unsigned c = xb_ld(&bar[XB_XCNT(j)]); sum += c; cnt += (c > 0u) ? 1u : 0u; mine = (j == x) ? c : mine; }
        if (sum == G) break;
        __builtin_amdgcn_s_sleep(1);
        if ((++sp & 255u) == 0u) { if (xb_ld(&bar[XB_TMO])) break; if (sp > XB_SPIN_CAP) { atomicAdd(&bar[XB_TMO], 1u); break; } }
    }
    nloc = mine > 0u ? mine : 1u; nx = cnt > 0u ? cnt : 1u;
}
__device__ __forceinline__ void xcd_barrier(const XcdBarrier& b, bool t0) {
    asm volatile("s_waitcnt vmcnt(0)" ::: "memory");
    __syncthreads();
    if (t0) {
        unsigned* bar = b.bar;
        __builtin_amdgcn_s_waitcnt(0);
        unsigned nloc = b.st[0], nx = b.st[1];
        if (nloc == 0u) { xcd_barrier_complete(bar, b.x, nloc, nx); b.st[0] = nloc; b.st[1] = nx; }
        const unsigned old = xb_add(&bar[XB_XSUB(b.x)], 1u);
        const unsigned gen = old / nloc;
        if (old + 1u == (gen + 1u) * nloc) {
            __builtin_amdgcn_fence(__ATOMIC_RELEASE, "agent");
            asm volatile("s_waitcnt vmcnt(0)" ::: "memory");
            const unsigned og = xb_add(&bar[XB_TOP], 1u);
            const unsigned tg = og / nx;
            if (og + 1u == (tg + 1u) * nx) xb_add(&bar[XB_TOPGEN], 1u);
            else XB_SPIN(xb_ld(&bar[XB_TOPGEN]) == tg, bar);
            __builtin_amdgcn_fence(__ATOMIC_ACQUIRE, "agent");
            xb_add(&bar[XB_XGEN(b.x)], 1u);
            asm volatile("s_waitcnt vmcnt(0)" ::: "memory");
        } else {
            XB_SPIN(xb_ld(&bar[XB_XGEN(b.x)]) == gen, bar);
            __builtin_amdgcn_fence(__ATOMIC_ACQUIRE, "agent");
            asm volatile("s_waitcnt vmcnt(0)" ::: "memory");
        }
    }
    __syncthreads();
}

constexpr int CW_XCC = 8192;
constexpr int CW_GRP = 8192 + 512;
constexpr int CW_GTMO = 8192 + 512 + 64 * 8;
__device__ __forceinline__ void group_barrier(unsigned* ctl, int gx, int ng, bool same_xcd, bool t0) {
    asm volatile("s_waitcnt vmcnt(0)" ::: "memory");
    __syncthreads();
    if (t0) {
        if (!same_xcd) { __builtin_amdgcn_fence(__ATOMIC_RELEASE, "agent"); }
        asm volatile("s_waitcnt vmcnt(0)" ::: "memory");
        unsigned* cnt = ctl + CW_GRP + 64 * gx;
        const unsigned old = xb_add(cnt, 1u);
        const unsigned target = (old / (unsigned)ng + 1u) * (unsigned)ng;
        unsigned sp = 0u;
        while (xb_ld(cnt) < target) { __builtin_amdgcn_s_sleep(1);
            if ((++sp & 255u) == 0u) { if (xb_ld(ctl + CW_GTMO)) break; if (sp > XB_SPIN_CAP) { atomicAdd(ctl + CW_GTMO, 1u); break; } } }
        __builtin_amdgcn_fence(__ATOMIC_ACQUIRE, "agent");
        asm volatile("s_waitcnt vmcnt(0)" ::: "memory");
    }
    __syncthreads();
}

struct Args { const float* in[17]; float* out; unsigned char* ws; int ph_lo, ph_hi; };
typedef const __attribute__((address_space(4))) Args CArgs;
struct Frame {
    LAS unsigned char* lds;
    int tid, lane, wave, vcu, G;
    int gx, gj, ng, grouped;
};
__device__ __forceinline__ float wave_sum(float v) {
#pragma unroll
    for (int o = 1; o < 64; o <<= 1) v += __shfl_xor(v, o);
    return v;
}

struct P0Job { const float* W; const float* gk; const float* sn; bf16* WT; int ldw, K, drow0; };
__device__ __forceinline__ P0Job p0_decode(CArgs* ap, int it) {
    constexpr int I_C1 = 16 * 64, I_C2 = 16 * 32, I_P = 4 * 8, I_M1 = 16 * 128, I_M2 = 64 * 32;
    constexpr int E_C1 = 2 * I_C1, E_C2 = E_C1 + 2 * I_C2, E_P = E_C2 + 8 * I_P, E_M1 = E_P + 4 * I_M1;
    unsigned char* ws = ap->ws; P0Job j; j.gk = nullptr; j.sn = nullptr;
    if (it < E_C1) { const int l = it / I_C1, r = it % I_C1, kb = r / 64, nb = r % 64, n0 = 32 * nb, k0 = 64 * kb;
        const int bj = n0 >> 10, rem = n0 & 1023; j.drow0 = 256 * (rem >> 7) + 128 * bj + (rem & 127); j.ldw = 2 * D; j.K = D;
        j.W = ap->in[3] + (size_t)l * D * 2 * D + (size_t)k0 * (2 * D) + n0; j.gk = ap->in[1] + (2 * l) * D + k0; j.WT = (bf16*)(ws + WS_WC1) + (size_t)l * 2 * D * D + k0; }
    else if (it < E_C2) { const int q = it - E_C1, l = q / I_C2, r = q % I_C2, k0 = 64 * (r / 32), n0 = 32 * (r % 32); j.drow0 = n0; j.ldw = D; j.K = D;
        j.W = ap->in[9] + (size_t)l * D * D + (size_t)k0 * D + n0; j.WT = (bf16*)(ws + WS_WC2) + (size_t)l * D * D + k0; }
    else if (it < E_P) { const int q = it - E_C2, lg = q / I_P, l = lg >> 2, g = lg & 3, r = q % I_P, k0 = 64 * (r / 8), n0 = 32 * (r % 8); j.drow0 = g * GW + n0; j.ldw = GW; j.K = GW;
        j.W = ap->in[11] + (size_t)lg * GW * GW + (size_t)k0 * GW + n0; j.gk = ap->in[1] + (2 * l + 1) * D + g * GW + k0; j.sn = ap->in[13] + l * D + g * GW + n0; j.WT = (bf16*)(ws + WS_WP) + (size_t)l * D * GW + k0; }
    else if (it < E_M1) { const int q = it - E_P, l = q / I_M1, r = q % I_M1, k0 = 64 * (r / 128), n0 = 32 * (r % 128); j.drow0 = n0; j.ldw = FF; j.K = D;
        j.W = ap->in[14] + (size_t)l * D * FF + (size_t)k0 * FF + n0; j.gk = ap->in[2] + l * D + k0; j.WT = (bf16*)(ws + WS_WM1) + (size_t)l * D * FF + k0; }
    else { const int q = it - E_M1, l = q / I_M2, r = q % I_M2, k0 = 64 * (r / 32), n0 = 32 * (r % 32); j.drow0 = n0; j.ldw = D; j.K = FF;
        j.W = ap->in[15] + (size_t)l * D * FF + (size_t)k0 * D + n0; j.WT = (bf16*)(ws + WS_WM2) + (size_t)l * D * FF + k0; }
    return j;
}
__device__ __forceinline__ void p0_load(const P0Job& j, float (&v)[32], int lane) {
    const float* p = j.W + (size_t)(lane >> 5) * j.ldw + (lane & 31);
#pragma unroll
    for (int i = 0; i < 32; ++i) v[i] = p[(size_t)(2 * i) * j.ldw];
}
__device__ __forceinline__ void p0_finish(const P0Job& j, const float (&v)[32], LAS float* scr, int lane) {
#pragma unroll
    for (int i = 0; i < 32; ++i) scr[(2 * i + (lane >> 5)) * 33 + (lane & 31)] = v[i];
    const int c = lane & 7;
    f32x4 g0 = {1.f, 1.f, 1.f, 1.f}, g1 = g0;
    if (j.gk) { g0 = *(const f32x4*)(j.gk + 8 * c); g1 = *(const f32x4*)(j.gk + 8 * c + 4); }
    LDS_WAIT(); asm volatile("" ::: "memory");
#pragma unroll
    for (int jj = 0; jj < 4; ++jj) { const int n = (lane >> 3) + 8 * jj; const LAS float* s = scr + (8 * c) * 33 + n; const float sc = j.sn ? j.sn[n] : 1.0f;
        v4u o; o.x = pk2(s[0 * 33] * g0.x * sc, s[1 * 33] * g0.y * sc); o.y = pk2(s[2 * 33] * g0.z * sc, s[3 * 33] * g0.w * sc); o.z = pk2(s[4 * 33] * g1.x * sc, s[5 * 33] * g1.y * sc); o.w = pk2(s[6 * 33] * g1.z * sc, s[7 * 33] * g1.w * sc);
        *(GAS v4u*)(j.WT + (size_t)(j.drow0 + n) * j.K + 8 * c) = o; }
    LDS_WAIT(); asm volatile("" ::: "memory");
}
constexpr int P0_NITEMS = 2 * 16 * 64 + 2 * 16 * 32 + 8 * 4 * 8 + 4 * 16 * 128 + 4 * 64 * 32, P0_FIRST = 16 * 64;
__device__ __forceinline__ void p0_items(const Frame& F, CArgs* ap, int first, int last, int st) {
    LAS float* scr = (LAS float*)(F.lds + RING_OFF + F.wave * 16384);
    if (first < last) {
        float vc[32], vn[32];
        P0Job job = p0_decode(ap, first); p0_load(job, vc, F.lane);
        for (int it = first; it < last; it += st) {
            const int itn = (it + st < last) ? it + st : it;
            const P0Job jobn = p0_decode(ap, itn); p0_load(jobn, vn, F.lane);
            __builtin_amdgcn_sched_barrier(0);
            p0_finish(job, vc, scr, F.lane);
            job = jobn;
#pragma unroll
            for (int i = 0; i < 32; ++i) vc[i] = vn[i];
        }
    }
}
__device__ __forceinline__ void p0a_phase(const Frame& F, CArgs* ap) {
    const int gw = F.vcu * NWAVES + F.wave, NGW = F.G * NWAVES;
    { const float* x = ap->in[0]; bf16* hb = (bf16*)(ap->ws + WS_HB); float* ss0 = (float*)(ap->ws + WS_SS);
      const int mb = F.grouped ? SEQ * F.gx : 0, ms = F.grouped ? 2 * (F.gj * NWAVES + F.wave) : 2 * gw, mst = F.grouped ? 2 * F.ng * NWAVES : 2 * NGW, mc = F.grouped ? SEQ : M;
      for (int ml = ms; ml < mc; ml += mst) { const int m = mb + ml;
        const GAS f32x4* xr = (const GAS f32x4*)(x + (size_t)m * D) + F.lane;
        f32x4 v[8];
#pragma unroll
        for (int j = 0; j < 8; ++j) v[j] = xr[64 * j];
        float s0 = 0.f, s1 = 0.f;
#pragma unroll
        for (int j = 0; j < 4; ++j) { s0 += (v[j].x * v[j].x + v[j].y * v[j].y) + (v[j].z * v[j].z + v[j].w * v[j].w); s1 += (v[4 + j].x * v[4 + j].x + v[4 + j].y * v[4 + j].y) + (v[4 + j].z * v[4 + j].z + v[4 + j].w * v[4 + j].w); }
        s0 = wave_sum(s0); s1 = wave_sum(s1);
        GAS v2u* o8 = (GAS v2u*)(hb + (size_t)m * D) + F.lane;
#pragma unroll
        for (int j = 0; j < 8; ++j) { v2u w; w.x = pk2(v[j].x, v[j].y); w.y = pk2(v[j].z, v[j].w); o8[64 * j] = w; }
        if (F.lane < 32) ss0[(size_t)m * 16 + F.lane] = (F.lane == 0) ? s0 : (F.lane == 16 ? s1 : 0.f);
      } }
    p0_items(F, ap, gw, P0_FIRST, NGW);
}
constexpr int CW_WDONE = 8192 + 512 + 64 * 9;
__device__ __forceinline__ void p0b_phase(const Frame& F, CArgs* ap) {
    constexpr int NB = P0_NITEMS - P0_FIRST;
    if (F.grouped) {
#if MK_SHARE == 0
        const int c0 = F.gx * F.gx, c1 = (F.gx + 1) * (F.gx + 1), ct = 64;
#elif MK_SHARE == 1
        const int c0 = F.gx * (F.gx - 1) / 2, c1 = F.gx * (F.gx + 1) / 2, ct = 28;
#elif MK_SHARE == 2
        const int c0 = (F.gx - 1) * F.gx * (2 * F.gx - 1) / 6, c1 = F.gx * (F.gx + 1) * (2 * F.gx + 1) / 6, ct = 140;
#else
        const int c0 = F.gx * F.gx + 2 * F.gx, c1 = (F.gx + 1) * (F.gx + 1) + 2 * (F.gx + 1), ct = 80;
#endif
        const int i0 = P0_FIRST + (int)(((long)NB * c0) / ct), i1 = P0_FIRST + (int)(((long)NB * c1) / ct);
        p0_items(F, ap, i0 + F.gj * NWAVES + F.wave, i1, F.ng * NWAVES); }
    else p0_items(F, ap, P0_FIRST + F.vcu * NWAVES + F.wave, P0_NITEMS, F.G * NWAVES);
    VM_WAIT(); __syncthreads();
    if (F.tid == 0) { __builtin_amdgcn_fence(__ATOMIC_RELEASE, "agent"); asm volatile("s_waitcnt vmcnt(0)" ::: "memory"); xb_add((unsigned*)(ap->ws + WS_CTL) + CW_WDONE, 1u); }
}
__device__ __forceinline__ void wait_weights(unsigned* ctl, volatile LAS unsigned* wst, unsigned G, bool t0) {
    if (wst[0] == 0u) {
        if (t0) { unsigned sp = 0u;
            while (xb_ld(ctl + CW_WDONE) < G) { __builtin_amdgcn_s_sleep(2); if ((++sp & 255u) == 0u) { if (xb_ld(ctl + CW_GTMO)) break; if (sp > XB_SPIN_CAP) { atomicAdd(ctl + CW_GTMO, 1u); break; } } }
            __builtin_amdgcn_fence(__ATOMIC_ACQUIRE, "agent"); asm volatile("s_waitcnt vmcnt(0)" ::: "memory");
            wst[0] = 1u; }
        __syncthreads();
    }
}

__device__ __forceinline__ float wave_reduce32(float (&v)[32], int lane) {
#define WR_STEP(NN, BIT) { const bool hi = (lane & (BIT)) != 0; _Pragma("unroll") for (int i = 0; i < (NN); ++i) { const float send = hi ? v[i] : v[i + (NN)], keep = hi ? v[i + (NN)] : v[i]; v[i] = keep + __shfl_xor(send, (BIT)); } }
    WR_STEP(16, 32) WR_STEP(8, 16) WR_STEP(4, 8) WR_STEP(2, 4) WR_STEP(1, 2)
#undef WR_STEP
    return v[0] + __shfl_xor(v[0], 1);
}
typedef float f32x2 __attribute__((ext_vector_type(2)));
constexpr int CR = 8, CWIN = CR + CW - 1;
template <int SKIP> __device__ __forceinline__ void conv_fma(const unsigned (&xr)[CWIN], const f32x2 (&w)[CW], f32x2 (&acc)[CR]) {
#pragma unroll
    for (int i = SKIP; i < CWIN; ++i) {
        const f32x2 xv = {bflo(xr[i]), bfhi(xr[i])};
#pragma unroll
        for (int r = 0; r < CR; ++r) { const int j = i - r; if (j >= 0 && j < CW) acc[r] += xv * w[j]; }
    }
}
__device__ __forceinline__ float wave_reduce16(float (&v)[16], int lane) {
#define WR_STEP(NN, BIT) { const bool hi = (lane & (BIT)) != 0; _Pragma("unroll") for (int i = 0; i < (NN); ++i) { const float send = hi ? v[i] : v[i + (NN)], keep = hi ? v[i + (NN)] : v[i]; v[i] = keep + __shfl_xor(send, (BIT)); } }
    WR_STEP(8, 32) WR_STEP(4, 16) WR_STEP(2, 8) WR_STEP(1, 4)
#undef WR_STEP
    float t = v[0] + __shfl_xor(v[0], 2); return t + __shfl_xor(t, 1);
}
__device__ __forceinline__ void conv_phase(const Frame& F, CArgs* ap, int l) {
    const bf16* U = (const bf16*)(ap->ws + WS_U); bf16* V = (bf16*)(ap->ws + WS_V);
    const int ch = 128 * F.wave + 2 * F.lane;
    const float* wdw = ap->in[5] + (size_t)l * CW * D + ch;
    const f32x2 bdw = *(const f32x2*)(ap->in[6] + l * D + ch), lg = *(const f32x2*)(ap->in[7] + l * D + ch), lb = *(const f32x2*)(ap->in[8] + l * D + ch);
    LAS float* red = (LAS float*)(F.lds + RING_OFF);
    int par = 0;
    constexpr int NIT = M / 64, IPS = SEQ / 64, NCH = 64 / CR;
    const unsigned voff = (unsigned)ch * 2u;
    const int ib = F.grouped ? IPS * F.gx : 0, is = F.grouped ? F.gj : F.vcu, ist = F.grouped ? F.ng : F.G, ic = F.grouped ? IPS : NIT;
    for (int il = is; il < ic; il += ist) { const int item = ib + il;
        const int sq = (item % IPS) * 64;
        const char* ub = (const char*)U + (size_t)(item / IPS) * SLAB + ((ptrdiff_t)sq - (CW - 1)) * (D * 2);
        unsigned xc[CWIN], xn[CR];
#pragma unroll
        for (int i = 0; i < CWIN; ++i) xc[i] = *(const unsigned*)(ub + (ptrdiff_t)i * (D * 2) + voff);
        f32x2 w[CW];
#pragma unroll
        for (int j = 0; j < CW; ++j) w[j] = *(const f32x2*)(wdw + (size_t)j * D);
#pragma unroll 1
        for (int c = 0; c < NCH; ++c) {
            const int cn = c < NCH - 1 ? c + 1 : NCH - 1;
#pragma unroll
            for (int i = 0; i < CR; ++i) xn[i] = *(const unsigned*)(ub + (ptrdiff_t)(CR * cn + CW - 1 + i) * (D * 2) + voff);
            __builtin_amdgcn_sched_barrier(0);
            f32x2 acc[CR];
#pragma unroll
            for (int r = 0; r < CR; ++r) acc[r] = bdw;
            const int s0 = sq + CR * c;
            if (s0 >= 32) conv_fma<0>(xc, w, acc);
            else if (s0 == 24) conv_fma<6>(xc, w, acc);
            else if (s0 == 16) conv_fma<14>(xc, w, acc);
            else if (s0 == 8) conv_fma<22>(xc, w, acc);
            else conv_fma<30>(xc, w, acc);
            float v[2 * CR];
#pragma unroll
            for (int r = 0; r < CR; ++r) { const f32x2 cc = acc[r]; v[2 * r] = cc.x + cc.y; v[2 * r + 1] = cc.x * cc.x + cc.y * cc.y; }
            const float tot = wave_reduce16(v, F.lane);
            LAS float* redp = red + (par ? 256 : 0); par ^= 1;
            if ((F.lane & 3) == 0) redp[((F.lane >> 3) * 8 + F.wave) * 2 + ((F.lane >> 2) & 1)] = tot;
            __syncthreads();
            float mean_l, rstd_l;
            { const LAS f32x4* pr = (const LAS f32x4*)(redp + (F.lane & 7) * 16);
              const f32x4 p0 = pr[0], p1 = pr[1], p2 = pr[2], p3 = pr[3];
              mean_l = (((p0.x + p0.z) + (p1.x + p1.z)) + ((p2.x + p2.z) + (p3.x + p3.z))) * (1.0f / D);
              const float ex2 = (((p0.y + p0.w) + (p1.y + p1.w)) + ((p2.y + p2.w) + (p3.y + p3.w))) * (1.0f / D);
              rstd_l = rsqrtf(fmaxf(ex2 - mean_l * mean_l, 0.f) + LN_EPS); }
            bf16* vb = V + (size_t)(item / IPS) * (SLAB / 2) + ((size_t)sq + CR * c) * D + ch;
#pragma unroll
            for (int r = 0; r < CR; ++r) {
                const float mean = __uint_as_float(__builtin_amdgcn_readlane(__float_as_uint(mean_l), r)), rstd = __uint_as_float(__builtin_amdgcn_readlane(__float_as_uint(rstd_l), r));
                f32x2 y = (acc[r] - mean) * (lg * rstd) + lb;
#pragma unroll
                for (int i = 0; i < 2; ++i) y[i] = y[i] * __builtin_amdgcn_rcpf(1.0f + __builtin_amdgcn_exp2f(y[i] * -1.44269504089f));
                *(unsigned*)(vb + (size_t)r * D) = pk2(y.x, y.y);
            }
#pragma unroll
            for (int i = 0; i < CW - 1; ++i) xc[i] = xc[i + CR];
#pragma unroll
            for (int i = 0; i < CR; ++i) xc[CW - 1 + i] = xn[i];
        }
    }
}

constexpr int PR = 8;
template <int W> __device__ __forceinline__ void pool_item(const bf16* hb, const float* ss, bf16* P, int b, int g, int s0, int lane) {
    constexpr int NR = PR + W - 1;
    const bf16* hp = hb + (size_t)b * SEQ * D + g * GW + 4 * lane;
    v2u hr[NR];
#pragma unroll
    for (int i = 0; i < NR; ++i) { const int s = s0 - (W - 1) + i, sc = s < 0 ? 0 : s; hr[i] = *(const v2u*)(hp + (size_t)sc * D); }
    float rs;
    { const int s = s0 - (W - 1) + lane, sc = s < 0 ? 0 : (s >= SEQ ? SEQ - 1 : s); const f32x4* p = (const f32x4*)(ss + ((size_t)b * SEQ + sc) * 16);
      const f32x4 p0 = p[0], p1 = p[1], p2 = p[2], p3 = p[3];
      const float t = ((p0.x + p0.y) + (p0.z + p0.w)) + ((p1.x + p1.y) + (p1.z + p1.w)) + ((p2.x + p2.y) + (p2.z + p2.w)) + ((p3.x + p3.y) + (p3.z + p3.w));
      rs = rsqrtf(t * (1.0f / D) + pg8::RMS_EPS); }
    f32x4 hn[NR];
#pragma unroll
    for (int i = 0; i < NR; ++i) { const int s = s0 - (W - 1) + i; const float r = (s < 0) ? 0.f : __shfl(rs, i); const f32x4 hv = {bflo(hr[i].x), bfhi(hr[i].x), bflo(hr[i].y), bfhi(hr[i].y)}; hn[i] = hv * r; }
    bf16* pp = P + (size_t)b * (SLAB / 2) + ((size_t)g * SEQ + s0) * GW + 4 * lane;
#pragma unroll
    for (int r = 0; r < PR; ++r) { f32x4 sum = hn[r];
#pragma unroll
        for (int j = 1; j < W; ++j) sum += hn[r + j];
        const int s = s0 + r; const float inv = 1.0f / (float)((s + 1) < W ? (s + 1) : W);
        const f32x4 p = sum * inv - hn[r + W - 1];
        v2u o; o.x = pk2(p.x, p.y); o.y = pk2(p.z, p.w); *(v2u*)(pp + (size_t)r * GW) = o; }
}
__device__ __forceinline__ void pool_phase(const Frame& F, CArgs* ap, const float* ss) {
    const bf16* hf = (const bf16*)(ap->ws + WS_HB); bf16* P = (bf16*)(ap->ws + WS_P);
    const int gw = F.vcu * NWAVES + F.wave, NGW = F.G * NWAVES;
    constexpr int PIB = NG * (SEQ / PR);
    const int ib = F.grouped ? PIB * F.gx : 0, is = F.grouped ? F.gj * NWAVES + F.wave : gw, ist = F.grouped ? F.ng * NWAVES : NGW, ic = F.grouped ? PIB : BATCH * PIB;
    for (int il = is; il < ic; il += ist) { const int it = ib + il;
        const int g = it & 3, q = it >> 2, b = q / (SEQ / PR), s0 = (q % (SEQ / PR)) * PR;
        if (g == 0) pool_item<2>(hf, ss, P, b, 0, s0, F.lane);
        else if (g == 1) pool_item<4>(hf, ss, P, b, 1, s0, F.lane);
        else if (g == 2) pool_item<8>(hf, ss, P, b, 2, s0, F.lane);
        else pool_item<16>(hf, ss, P, b, 3, s0, F.lane);
    }
}

__device__ __forceinline__ void final_phase(const Frame& F, CArgs* ap, const float* ss) {
    const int gw = F.vcu * NWAVES + F.wave, NGW = F.G * NWAVES;
    const float* fn = ap->in[16]; float* out = ap->out; const bf16* hb = (const bf16*)(ap->ws + WS_HB);
    f32x4 gn[4];
#pragma unroll
    for (int j = 0; j < 4; ++j) gn[j] = *(const f32x4*)(fn + 4 * F.lane + 256 * j);
    const int mb = F.grouped ? SEQ * F.gx : 0, ms = F.grouped ? 2 * (F.gj * NWAVES + F.wave) : 2 * gw, mst = F.grouped ? 2 * F.ng * NWAVES : 2 * NGW, mc = F.grouped ? SEQ : M;
    for (int ml = ms; ml < mc; ml += mst) { const int m = mb + ml;
        float t = ss[(size_t)m * 16 + (F.lane & 31)];
        const GAS v2u* hr = (const GAS v2u*)(hb + (size_t)m * D) + F.lane;
        v2u raw[8];
#pragma unroll
        for (int j = 0; j < 8; ++j) raw[j] = hr[64 * j];
        t += __shfl_xor(t, 1); t += __shfl_xor(t, 2); t += __shfl_xor(t, 4); t += __shfl_xor(t, 8);
        const float rs0 = rsqrtf(__shfl(t, 0) * (1.0f / D) + pg8::RMS_EPS), rs1 = rsqrtf(__shfl(t, 16) * (1.0f / D) + pg8::RMS_EPS);
        GAS f32x4* ho = (GAS f32x4*)(out + (size_t)m * D) + F.lane;
#pragma unroll
        for (int j = 0; j < 8; ++j) { const f32x4 hv = {bflo(raw[j].x), bfhi(raw[j].x), bflo(raw[j].y), bfhi(raw[j].y)}; ho[64 * j] = hv * (j < 4 ? rs0 : rs1) * gn[j & 3]; }
    }
}

constexpr int NPH = 21;
constexpr int TAB_OFF = LDSCTL_OFF + 1024;
__global__ void __launch_bounds__(NWAVES * 64, 2) enc_fwd(Args args) {
    extern __shared__ __attribute__((aligned(16))) unsigned char lds[];
    LAS unsigned char* const ldsb = (LAS unsigned char*)lds;
    CArgs* ap = (CArgs*)__builtin_amdgcn_kernarg_segment_ptr();
    for (int u = threadIdx.x; u < (LDS_BYTES - LDSCTL_OFF) / 4; u += NWAVES * 64) ((LAS unsigned*)(ldsb + LDSCTL_OFF))[u] = 0u;
    __syncthreads();
#if !MK_PER_PHASE
    const XcdBarrier bar = xcd_barrier_post((unsigned*)(ap->ws + WS_CTL) + CW_BAR, (volatile LAS unsigned*)(ldsb + MISC_OFF) + 8);
    if (threadIdx.x == 0 && gridDim.x <= 256) __hip_atomic_store((unsigned*)(ap->ws + WS_CTL) + CW_XCC + blockIdx.x, bar.x + 1u, __ATOMIC_RELAXED, __HIP_MEMORY_SCOPE_AGENT);
    volatile LAS unsigned* const gst = (volatile LAS unsigned*)(ldsb + MISC_OFF) + 16;
#endif
    PG8_LAS float* const tab = (PG8_LAS float*)(ldsb + TAB_OFF);
    const int wave_s = __builtin_amdgcn_readfirstlane((int)threadIdx.x >> 6);
    const int ph_hi = ap->ph_hi;
    for (int ph = ap->ph_lo; ph < ph_hi; ++ph) {
      int nrep = 1;
      if (MK_PROBE) { const int r_ = (ph - 2) % 9; const bool mid = ph > 1 && ph < NPH - 1;
          if (((MK_PROBE & 1) && ph <= 1) || (mid && (((MK_PROBE & 2) && r_ == 0) || ((MK_PROBE & 4) && r_ == 1) || ((MK_PROBE & 8) && (r_ == 3 || r_ == 7)) || ((MK_PROBE & 16) && r_ == (MK_FUSE_POOL ? 6 : 5))))) nrep = 2; }
      for (int rep = 0; rep < nrep; ++rep) {
        asm volatile("" : "+s"(ap));
        int bid = blockIdx.x, G = gridDim.x;
        asm volatile("" : "+s"(bid), "+s"(G));
        Frame F; F.lds = ldsb; F.tid = 0; F.lane = 0; F.wave = wave_s; F.G = G;
#define MKF() do { F.lane = pg8::lane_now(); F.tid = wave_s * 64 + F.lane; } while (0)
        F.vcu = (G % 8 == 0) ? (bid % 8) * (G / 8) + bid / 8 : bid;
        F.grouped = (G == 256); F.gx = bid % 8; F.gj = bid / 8; F.ng = G / 8;
        unsigned char* const ws = ap->ws; float* const SS = (float*)(ws + WS_SS);
        volatile LAS unsigned* const wst = (volatile LAS unsigned*)(ldsb + MISC_OFF) + 20;
        if (ph >= 4) wait_weights((unsigned*)(ws + WS_CTL), wst, (unsigned)G, wave_s * 64 + pg8::lane_now() == 0);
        if (ph == 0) {
#ifndef NO_P0
            asm volatile("; MARK P0 begin"); MKF(); p0a_phase(F, ap); asm volatile("; MARK P0 end");
#endif
        }
        else if (ph == 1) {
#ifndef NO_P0
            MKF(); p0b_phase(F, ap);
#endif
        }
        else if (ph == NPH - 1) {
#ifndef NO_FINAL
            asm volatile("; MARK FINAL begin"); MKF(); final_phase(F, ap, SS + (size_t)8 * M * 16); asm volatile("; MARK FINAL end");
#endif
        }
        else {
            const int q = ph - 2, lp = q / 9, r = q % 9, i = 2 * lp + (r >= 5 ? 1 : 0);
            bf16* const hbA = (bf16*)(ws + WS_HB); bf16* const hbB = (bf16*)((unsigned char*)ap->out + OUT_HB2);
            bf16* const hbc = (MK_FUSE_POOL && ((lp == 0 && r >= 7) || (lp == 1 && r <= 4))) ? hbB : hbA;
            const int kin = (r == 0 || r == 5) ? 2 * i : 2 * i + 1;
            if (r == 0) {
                pg8::Gemm g{hbc, (const bf16*)(ws + WS_WC1) + (size_t)lp * 2 * D * D, M, 2 * D, D, 0, (size_t)SEQ * D * 2}; pg8::StaticOrder S; S.init(M, 2 * D, G, bid);
                pg8::EpiGlu E{(bf16*)(ws + WS_U), ap->in[4] + lp * 2 * D, SS + (size_t)kin * M * 16, tab};
#ifndef NO_G1
                asm volatile("; MARK G1 begin"); pg8::gemm_phase<pg8::EpiGlu, pg8::StaticOrder, true, true>(F.lds + RING_OFF, g, S, E, wave_s * 64 + pg8::lane_now()); asm volatile("; MARK G1 end");
#endif
            } else if (r == 1) {
#ifndef NO_CONV
                asm volatile("; MARK CONV begin"); MKF(); conv_phase(F, ap, lp); asm volatile("; MARK CONV end");
#endif
            }
            else if (r == 5) { if (!MK_FUSE_POOL) {
#ifndef NO_POOL
                asm volatile("; MARK POOL begin"); MKF(); pool_phase(F, ap, SS + (size_t)kin * M * 16); asm volatile("; MARK POOL end");
#endif
            } }
            else if (r == 3 || r == 7) {
                pg8::Gemm g{hbc, (const bf16*)(ws + WS_WM1) + (size_t)i * D * FF, M, FF, D, 0, (size_t)SEQ * D * 2}; typedef std::conditional<(MK_PROBE & 64) != 0, pg8::TwiceOrder, pg8::StaticOrder>::type Ord3; Ord3 S; S.init(M, FF, G, bid);
                pg8::EpiRelu2 E{(bf16*)(ws + WS_T), FF, SS + (size_t)kin * M * 16, tab};
#ifndef NO_G3
                asm volatile("; MARK G3 begin"); pg8::gemm_phase<pg8::EpiRelu2, Ord3, true, true>(F.lds + RING_OFF, g, S, E, wave_s * 64 + pg8::lane_now()); asm volatile("; MARK G3 end");
#endif
            } else {
                pg8::Gemm g; const float* mbias = nullptr; const float* mbscale = nullptr; int kout;
                if (r == 2) { g = pg8::Gemm{(const bf16*)(ws + WS_V), (const bf16*)(ws + WS_WC2) + (size_t)lp * D * D, M, D, D, 0, SLAB}; mbias = ap->in[10] + lp * D; kout = 2 * i + 1; }
                else if (r == 6) { g = pg8::Gemm{(const bf16*)(ws + WS_P), (const bf16*)(ws + WS_WP) + (size_t)lp * D * GW, M, D, GW, (size_t)SEQ * GW * 2, SLAB}; mbias = ap->in[12] + lp * D; mbscale = ap->in[13] + lp * D; kout = 2 * i + 1; }
                else { g = pg8::Gemm{(const bf16*)(ws + WS_T), (const bf16*)(ws + WS_WM2) + (size_t)i * D * FF, M, D, FF, 0, SLAB}; kout = 2 * i + 2; }
                typedef std::conditional<(MK_PROBE & 128) != 0, pg8::TwiceOrder, pg8::StaticOrder>::type Ord2; Ord2 S; S.init(M, D, G, bid);
                if (MK_FUSE_POOL && r == 6) {
                    pg8::StaticOrder Sp; Sp.init(M, D, G, bid);
                    bf16* const hin_ = (lp == 0) ? hbA : hbB; bf16* const hout_ = (lp == 0) ? hbB : hbA;
                    pg8::EpiRes Ep{hout_, mbias, mbscale, SS + (size_t)kout * M * 16, hin_};
                    const pg8::PoolSrc psrc{hin_, SS + (size_t)(2 * i) * M * 16};
                    pg8::pool_gemm_phase<pg8::EpiRes, pg8::StaticOrder>(F.lds + RING_OFF, (const bf16*)(ws + WS_WP) + (size_t)lp * D * GW, psrc, Sp, Ep, wave_s * 64 + pg8::lane_now());
                } else {
                pg8::EpiRes E{hbc, mbias, mbscale, SS + (size_t)kout * M * 16, hbc};
#ifndef NO_G2
                asm volatile("; MARK G2 begin"); pg8::gemm_phase<pg8::EpiRes, Ord2, true, true>(F.lds + RING_OFF, g, S, E, wave_s * 64 + pg8::lane_now()); asm volatile("; MARK G2 end");
#endif
                }
            }
        }
#if !MK_PER_PHASE
        const int tid = wave_s * 64 + pg8::lane_now();
        if (ph + 1 < ph_hi && !(MK_FUSE_POOL && ph > 1 && ph < NPH - 1 && (ph - 2) % 9 == 5)) {
            if (ph == 1 && F.grouped) { }
            else if (ph == 0 || !F.grouped || (MK_FUSE_POOL && ph == NPH - 2)) { xcd_barrier(bar, tid == 0); if (MK_PROBE & 32) xcd_barrier(bar, tid == 0); }
            else {
                unsigned* ctl = (unsigned*)(ap->ws + WS_CTL);
                if (gst[0] == 0u) {
                    if (tid == 0) { unsigned same = 1u;
                        for (int k = 0; k < F.ng; ++k) same &= (xb_ld(ctl + CW_XCC + F.gx + 8 * k) == bar.x + 1u) ? 1u : 0u;
                        gst[0] = same ? 1u : 2u; }
                    __syncthreads();
                }
                const bool same_xcd = gst[0] == 1u;
                group_barrier(ctl, F.gx, F.ng, same_xcd, tid == 0); if (MK_PROBE & 32) group_barrier(ctl, F.gx, F.ng, same_xcd, tid == 0);
            }
        }
#endif
#undef MKF
      }
    }
}

extern "C" void kernel_launch(void* const* d_in, const int* in_sizes, int n_in, void* d_out, int out_size, void* d_ws, size_t ws_size, hipStream_t stream) {
    static int grid = 0;
    if (grid == 0) {
        if (n_in != 17 || in_sizes[0] != M * D || out_size != M * D || ws_size < WS_END) { fprintf(stderr, "kernel_launch: unexpected shapes (n_in %d, in0 %d, out %d, ws %zu); nothing launched\n", n_in, n_in > 0 ? in_sizes[0] : -1, out_size, ws_size); grid = -1; return; }
        int dev = 0, cus = 0, per_cu = 0;
        if (hipGetDevice(&dev) != hipSuccess || hipDeviceGetAttribute(&cus, hipDeviceAttributeMultiprocessorCount, dev) != hipSuccess) { grid = -1; return; }
        if (hipFuncSetAttribute((const void*)enc_fwd, hipFuncAttributeMaxDynamicSharedMemorySize, LDS_BYTES) != hipSuccess) { fprintf(stderr, "kernel_launch: hipFuncSetAttribute failed\n"); grid = -1; return; }
        if (hipOccupancyMaxActiveBlocksPerMultiprocessor(&per_cu, (const void*)enc_fwd, NWAVES * 64, LDS_BYTES) != hipSuccess || per_cu < 1) { fprintf(stderr, "kernel_launch: occupancy query reports %d workgroups per CU\n", per_cu); }
        (void)hipGetLastError();
        grid = cus;
    }
    if (grid < 0) return;
    (void)hipMemsetAsync((char*)d_ws + WS_CTL, 0, CTL_ZERO_BYTES, stream);
    Args a{};
    for (int i = 0; i < 17; ++i) a.in[i] = (const float*)d_in[i];
    a.out = (float*)d_out; a.ws = (unsigned char*)d_ws;
#if MK_PER_PHASE
    for (int p = 0; p < NPH; ++p) { a.ph_lo = p; a.ph_hi = p + 1; hipLaunchKernelGGL(enc_fwd, dim3(grid), dim3(NWAVES * 64), LDS_BYTES, stream, a); }
#else
    a.ph_lo = 0; a.ph_hi = NPH;
    hipLaunchKernelGGL(enc_fwd, dim3(grid), dim3(NWAVES * 64), LDS_BYTES, stream, a);
#endif
}
```

```cpp
#include <hip/hip_runtime.h>
#include <cstdio>
#include <cstdint>
#include <type_traits>

#ifndef MK_PROBE
#define MK_PROBE 0
#endif
#ifndef MK_SHARE
#define MK_SHARE 3
#endif
#ifndef MK_EPI_DEPTH
#define MK_EPI_DEPTH 2
#endif
#ifndef MK_LDS2X
#define MK_LDS2X 0
#endif
#ifndef MK_EPI_OVL
#define MK_EPI_OVL 1
#endif
#ifndef MK_FUSE_FINAL
#define MK_FUSE_FINAL 1
#endif
#ifndef MK_LAZY0
#define MK_LAZY0 1
#endif
#ifndef MK_BAL
#define MK_BAL 1
#endif
#ifndef MK_PIPE
#define MK_PIPE 0
#endif
#ifndef MK_FUSE_POOL
#define MK_FUSE_POOL 1
#endif
#ifndef MK_PER_PHASE
#define MK_PER_PHASE 0
#endif

namespace pg8 {
#define PG8_LAS __attribute__((address_space(3)))
typedef unsigned short bf16_t;
typedef short bf16x8 __attribute__((ext_vector_type(8)));
typedef float f32x4 __attribute__((ext_vector_type(4)));
typedef unsigned u32x4 __attribute__((ext_vector_type(4)));
typedef unsigned u32x2 __attribute__((ext_vector_type(2)));
constexpr int BM = 256, BK = 64, HALF = 128, HTB = HALF * BK * 2  , STAGE_BYTES = 8 * HTB, NXCD = 8, WGM = 8;

__host__ __device__ __forceinline__ int lds_byte(int r, int c) { const int st = (r >> 4) * 2 + (c >> 5), rr = r & 15, cc = c & 31, ob = rr * 64 + cc * 2; return st * 1024 + (ob ^ (((ob >> 9) & 1) << 5)); }
__host__ __device__ __forceinline__ void stage_rc(int b, int& R, int& C) { const int st = b / 1024, sb = b % 1024, swz = sb ^ (((sb >> 9) & 1) << 5); R = (st >> 1) * 16 + swz / 64; C = (st & 1) * 32 + (swz % 64) / 2; }
__host__ __device__ __forceinline__ int perm32(int rho) { const int n = rho >> 4, i = rho & 15; return 8 * (i >> 2) + 4 * n + (i & 3); }

__device__ __forceinline__ int lane_now() { unsigned z = 0u; asm volatile("" : "+v"(z)); return (int)__builtin_amdgcn_mbcnt_hi(~0u, __builtin_amdgcn_mbcnt_lo(~0u, z)); }
struct Unit { int pm, pn; };
struct Gemm { const bf16_t* A; const bf16_t* Bt; int M, N, K; size_t a_pn_stride, a_bstride; };

struct StaticOrder {
    int nM, nN, nwg, G, c;
    __host__ __device__ void init(int M, int N, int G_, int c_) { nM = M / BM; nN = N / BM; nwg = nM * nN; G = G_; c = c_; }
    __host__ __device__ bool next(int i, Unit& u) const {
        const long L = (long)i * G + c; if (L >= nwg) return false;
        int wgid = (int)L; { const int q = nwg / NXCD, r = nwg % NXCD, xcd = wgid % NXCD, off = wgid / NXCD; wgid = (xcd < r ? xcd * (q + 1) : r * (q + 1) + (xcd - r) * q) + off; }
        const int nig = WGM * nN, gid = wgid / nig, fm = gid * WGM, gsz = (nM - fm) < WGM ? (nM - fm) : WGM;
        u.pm = fm + ((wgid % nig) % gsz); u.pn = (wgid % nig) / gsz; return true;
    }
    __device__ __forceinline__ void a_ready(const Unit&) const {}
    __device__ __forceinline__ void done(const Unit&) const {}
    static constexpr bool TWICE = false;
};
struct TwiceOrder : StaticOrder {
    __host__ __device__ bool next(int i, Unit& u) const { return StaticOrder::next(i >> 1, u); }
    static constexpr bool TWICE = true;
};

__device__ __forceinline__ unsigned cvt_pk_bf16(float lo, float hi) { unsigned r; asm volatile("v_cvt_pk_bf16_f32 %0, %1, %2" : "=v"(r) : "v"(lo), "v"(hi)); return r; }
constexpr float RMS_EPS = 1e-6f;

__device__ __forceinline__ void rows_rstd(const float* ss, int pm, PG8_LAS float* tab, int wr, int fr, int t, bool rebuild, float (&rs)[2][4]) {
    if (rebuild) {
        const int row = t >> 1, hf = t & 1;
        const f32x4* p = (const f32x4*)(ss + ((size_t)pm * BM + row) * 16 + 8 * hf);
        const f32x4 a = p[0], b = p[1]; float s = ((a[0] + a[1]) + (a[2] + a[3])) + ((b[0] + b[1]) + (b[2] + b[3]));
        s += __shfl_xor(s, 1);
        if (hf == 0) tab[row] = rsqrtf(s * (1.0f / 1024.0f) + RMS_EPS);
        asm volatile("s_waitcnt lgkmcnt(0)" ::: "memory"); __builtin_amdgcn_s_barrier(); asm volatile("" ::: "memory");
    }
#pragma unroll
    for (int ai = 0; ai < 2; ++ai)
#pragma unroll
        for (int m = 0; m < 4; ++m) rs[ai][m] = tab[ai * HALF + wr * 64 + m * 16 + fr];
}


struct EpiGlu {
    static constexpr bool PERM = true, AFTER_DRAIN = false;
    bf16_t* U; const float* bias; const float* ss; PG8_LAS float* tab;
    __device__ __forceinline__ void operator()(const f32x4 (&acc)[2][2][4][2], const Unit& u, int wr, int wc, int fr, int fq, int tid, int& tab_pm) const {
        const int row0 = u.pm * BM + wr * 64 + fr, col0 = u.pn * HALF + wc * 32 + 8 * fq;
        float rs[2][4]; rows_rstd(ss, u.pm, tab, wr, fr, tid, tab_pm != u.pm, rs); tab_pm = u.pm;
        f32x4 ba[2], bg[2];
#pragma unroll
        for (int n = 0; n < 2; ++n) { ba[n] = *(const f32x4*)(bias + col0 + 4 * n); bg[n] = *(const f32x4*)(bias + 1024 + col0 + 4 * n); }
#pragma unroll
        for (int ai = 0; ai < 2; ++ai)
#pragma unroll
            for (int m = 0; m < 4; ++m) { const float r = rs[ai][m]; float o[8];
#pragma unroll
                for (int n = 0; n < 2; ++n)
#pragma unroll
                    for (int i = 0; i < 4; ++i) { const float a = acc[ai][0][m][n][i] * r + ba[n][i], g = acc[ai][1][m][n][i] * r + bg[n][i];
                        o[4 * n + i] = a * __builtin_amdgcn_rcpf(1.0f + __builtin_amdgcn_exp2f(g * -1.44269504089f)); }
                u32x4 w; w.x = cvt_pk_bf16(o[0], o[1]); w.y = cvt_pk_bf16(o[2], o[3]); w.z = cvt_pk_bf16(o[4], o[5]); w.w = cvt_pk_bf16(o[6], o[7]);
                { const int row = row0 + ai * HALF + m * 16; *(u32x4*)(U + (size_t)(row >> 11) * (16u << 19) + (size_t)(row & 2047) * 1024 + col0) = w; } }
    }
};
struct EpiRelu2 {
    static constexpr bool PERM = true, AFTER_DRAIN = false;
    bf16_t* T; int ldc; const float* ss; PG8_LAS float* tab;
    __device__ __forceinline__ void operator()(const f32x4 (&acc)[2][2][4][2], const Unit& u, int wr, int wc, int fr, int fq, int tid, int& tab_pm) const {
        const int row0 = u.pm * BM + wr * 64 + fr, col0 = u.pn * BM + wc * 32 + 8 * fq;
        float rs[2][4]; rows_rstd(ss, u.pm, tab, wr, fr, tid, tab_pm != u.pm, rs); tab_pm = u.pm;
#pragma unroll
        for (int ai = 0; ai < 2; ++ai)
#pragma unroll
            for (int m = 0; m < 4; ++m) { const float r = rs[ai][m]; bf16_t* rowp = T + (size_t)(row0 + ai * HALF + m * 16) * ldc + col0;
#pragma unroll
                for (int bj = 0; bj < 2; ++bj) { f32x4 v0 = acc[ai][bj][m][0] * r, v1 = acc[ai][bj][m][1] * r;
#pragma unroll
                    for (int i = 0; i < 4; ++i) { v0[i] = fmaxf(v0[i], 0.f); v1[i] = fmaxf(v1[i], 0.f); }
                    v0 = v0 * v0; v1 = v1 * v1;
                    u32x4 w; w.x = cvt_pk_bf16(v0[0], v0[1]); w.y = cvt_pk_bf16(v0[2], v0[3]); w.z = cvt_pk_bf16(v1[0], v1[1]); w.w = cvt_pk_bf16(v1[2], v1[3]);
                    *(u32x4*)(rowp + bj * HALF) = w; } }
    }
};
struct EpiRes {
    static constexpr bool PERM = true, AFTER_DRAIN = false;
    bf16_t* hb; const float* bias; const float* bscale; float* ss; const bf16_t* hin;
    __device__ __forceinline__ void operator()(const f32x4 (&acc)[2][2][4][2], const Unit& u, int wr, int wc, int fr, int fq, int tid, int& tab_pm) const {
        const int row0 = u.pm * BM + wr * 64 + fr, col0 = u.pn * BM + wc * 32 + 8 * fq;
        f32x4 bv[2][2] = {{{0.f, 0.f, 0.f, 0.f}, {0.f, 0.f, 0.f, 0.f}}, {{0.f, 0.f, 0.f, 0.f}, {0.f, 0.f, 0.f, 0.f}}};
        if (bias) {
            const float* bs = bscale ? bscale : bias;
            f32x4 b[2][2], c[2][2];
#pragma unroll
            for (int bj = 0; bj < 2; ++bj)
#pragma unroll
                for (int n = 0; n < 2; ++n) { b[bj][n] = *(const f32x4*)(bias + col0 + bj * HALF + 4 * n); c[bj][n] = *(const f32x4*)(bs + col0 + bj * HALF + 4 * n); }
#pragma unroll
            for (int bj = 0; bj < 2; ++bj)
#pragma unroll
                for (int n = 0; n < 2; ++n) bv[bj][n] = bscale ? b[bj][n] * c[bj][n] : b[bj][n];
        }
        constexpr int DEPTH = MK_EPI_DEPTH;
        u32x4 pre[8][2];
#pragma unroll
        for (int g = 0; g < DEPTH; ++g)
#pragma unroll
            for (int bj = 0; bj < 2; ++bj) pre[g][bj] = *(const u32x4*)(hin + (size_t)(row0 + (g >> 2) * HALF + (g & 3) * 16) * 1024 + col0 + bj * HALF);
#pragma unroll
        for (int g = 0; g < 8; ++g) { const int ai = g >> 2, m = g & 3; const int row = row0 + ai * HALF + m * 16; const size_t off = (size_t)row * 1024 + col0; float q = 0.f;
            if (g + DEPTH < 8) {
#pragma unroll
                for (int bj = 0; bj < 2; ++bj) pre[g + DEPTH][bj] = *(const u32x4*)(hin + (size_t)(row0 + ((g + DEPTH) >> 2) * HALF + ((g + DEPTH) & 3) * 16) * 1024 + col0 + bj * HALF); }
#pragma unroll
            for (int bj = 0; bj < 2; ++bj) { const u32x4 o = pre[g][bj];
                f32x4 v0 = {__uint_as_float(o.x << 16), __uint_as_float(o.x & 0xffff0000u), __uint_as_float(o.y << 16), __uint_as_float(o.y & 0xffff0000u)};
                f32x4 v1 = {__uint_as_float(o.z << 16), __uint_as_float(o.z & 0xffff0000u), __uint_as_float(o.w << 16), __uint_as_float(o.w & 0xffff0000u)};
                v0 = v0 + acc[ai][bj][m][0] + bv[bj][0]; v1 = v1 + acc[ai][bj][m][1] + bv[bj][1];
                u32x4 w; w.x = cvt_pk_bf16(v0[0], v0[1]); w.y = cvt_pk_bf16(v0[2], v0[3]); w.z = cvt_pk_bf16(v1[0], v1[1]); w.w = cvt_pk_bf16(v1[2], v1[3]);
                *(u32x4*)(hb + off + bj * HALF) = w;
                q += (v0[0] * v0[0] + v0[1] * v0[1]) + (v0[2] * v0[2] + v0[3] * v0[3]) + (v1[0] * v1[0] + v1[1] * v1[1]) + (v1[2] * v1[2] + v1[3] * v1[3]); }
            q += __shfl_xor(q, 16); q += __shfl_xor(q, 32);
            if (fq == 0) ss[(size_t)row * 16 + u.pn * 4 + wc] = q; }
    }
};

struct NoSeam { __device__ __forceinline__ void operator()() const {} };
template <class Epi, class Sched, bool ALIGN_EPI = false, bool SP2 = false, class Seam = NoSeam>
__device__ __forceinline__ void gemm_phase(PG8_LAS unsigned char* lds, const Gemm g, const Sched& S, const Epi& E, const int tid, const Seam& W = Seam()) {
    const int wid = __builtin_amdgcn_readfirstlane(tid >> 6), lane = tid & 63, wr = wid >> 2, wc = wid & 3, fr = lane & 15, fq = lane >> 4;
    const int K = g.K, nt = K / BK;
    unsigned voffA[2], voffB[2];
#pragma unroll
    for (int i = 0; i < 2; ++i) { int R, C; stage_rc(tid * 16 + i * 8192, R, C); const int Rb = Epi::PERM ? ((R & ~31) + perm32(R & 31)) : R;
        voffA[i] = (unsigned)(R * K + C) * 2u; voffB[i] = (unsigned)(Rb * K + C) * 2u; }
    const unsigned kstep = (unsigned)(BK * 2), hstep = (unsigned)(HALF * K * 2), tstep = 2 * hstep;
    const unsigned pstep = (unsigned)(32 * K * 2);
    const __amdgpu_buffer_rsrc_t srdA = __builtin_amdgcn_make_buffer_rsrc((void*)g.A, (short)0, 0x7fffffff, 0x00020000), srdB = __builtin_amdgcn_make_buffer_rsrc((void*)g.Bt, (short)0, 0x7fffffff, 0x00020000);
    const unsigned ldsw = (unsigned)wid * 1024u;
    const int aoff = lds_byte(wr * 64 + fr, fq * 8), boff = lds_byte(wc * 32 + fr, fq * 8);
#define PG8_SA(b, h) (((b) * 2 + (h)) * HTB)
#define PG8_SB(b, h) ((4 + (b) * 2 + (h)) * HTB)
#define PG8_STAGE(bufoff, srd, soff, voff) do { _Pragma("unroll") for (int _i = 0; _i < 2; ++_i) \
        __builtin_amdgcn_raw_ptr_buffer_load_lds(srd, (PG8_LAS unsigned*)(lds + (bufoff) + ldsw + _i * 8192), 16, (voff)[_i], (soff), 0, 0); } while (0)
#define PG8_LDA1(dst, b, h) do { _Pragma("unroll") for (int m = 0; m < 4; ++m) _Pragma("unroll") for (int k = 0; k < 2; ++k) dst[m][k] = *(const PG8_LAS bf16x8*)(lds + PG8_SA(b, h) + aoff + m * 2048 + k * 1024); } while (0)
#if MK_LDS2X
#define PG8_LDA(dst, b, h) do { PG8_LDA1(dst, b, h); _Pragma("unroll") for (int m = 0; m < 4; ++m) _Pragma("unroll") for (int k = 0; k < 2; ++k) asm volatile("" : "+v"(dst[m][k])); asm volatile("" ::: "memory"); PG8_LDA1(dst, b, h); } while (0)
#else
#define PG8_LDA(dst, b, h) PG8_LDA1(dst, b, h)
#endif
#define PG8_LDB(dst, b, h) do { _Pragma("unroll") for (int n = 0; n < 2; ++n) _Pragma("unroll") for (int k = 0; k < 2; ++k) dst[n][k] = *(const PG8_LAS bf16x8*)(lds + PG8_SB(b, h) + boff + n * 2048 + k * 1024); } while (0)
#define PG8_MMA(ai, bj, At, Bt) do { __builtin_amdgcn_s_setprio(1); _Pragma("unroll") for (int m = 0; m < 4; ++m) _Pragma("unroll") for (int n = 0; n < 2; ++n) _Pragma("unroll") for (int k = 0; k < 2; ++k) \
        acc[ai][bj][m][n] = __builtin_amdgcn_mfma_f32_16x16x32_bf16(Bt[n][k], At[m][k], acc[ai][bj][m][n], 0, 0, 0); __builtin_amdgcn_s_setprio(0); } while (0)
#define PG8_WAIT_V(n) asm volatile("s_waitcnt vmcnt(" #n ")" ::: "memory")
#define PG8_WAIT_L(n) asm volatile("s_waitcnt lgkmcnt(" #n ")" ::: "memory")
#define PG8_BAR __builtin_amdgcn_s_barrier()
#define PG8_SCHED __builtin_amdgcn_sched_barrier(0)
    Unit cur, nxt; int ui = 0, tab_pm = -1;
    if (!S.next(0, cur)) return;
    f32x4 acc[2][2][4][2];
#pragma unroll
    for (int a = 0; a < 2; ++a)
#pragma unroll
        for (int b = 0; b < 2; ++b)
#pragma unroll
            for (int m = 0; m < 4; ++m)
#pragma unroll
                for (int n = 0; n < 2; ++n) acc[a][b][m][n] = (f32x4){0.f, 0.f, 0.f, 0.f};
    constexpr bool PIPE = SP2 && (MK_PIPE != 0);
    bf16x8 At[4][2], B0[2][2], B1[2][2]; bf16x8 Au[PIPE ? 4 : 1][2];
#define PG8_STAGE4(b, pa, pb) do { PG8_STAGE(PG8_SB(b, 0), srdB, (pb), voffB); PG8_STAGE(PG8_SB(b, 1), srdB, (pb) + hstep, voffB); PG8_STAGE(PG8_SA(b, 0), srdA, (pa), voffA); PG8_STAGE(PG8_SA(b, 1), srdA, (pa) + hstep, voffA); } while (0)
    unsigned cA = (unsigned)(cur.pm >> 3) * (unsigned)g.a_bstride + (unsigned)(cur.pm & 7) * tstep + (unsigned)cur.pn * (unsigned)g.a_pn_stride, cB = (unsigned)cur.pn * tstep;
    S.a_ready(cur);
    if constexpr (!(SP2 && !PIPE && MK_BAL != 0)) W();
    if constexpr (PIPE) {
        PG8_STAGE4(0, cA, cB); PG8_STAGE4(1, cA + kstep, cB + kstep);
        PG8_WAIT_V(8); PG8_BAR;
    } else if constexpr (SP2 && MK_BAL != 0) {
        PG8_STAGE(PG8_SB(0, 0), srdB, cB, voffB); PG8_STAGE(PG8_SB(0, 1), srdB, cB + hstep, voffB); PG8_STAGE(PG8_SB(1, 0), srdB, cB + kstep, voffB); PG8_STAGE(PG8_SB(1, 1), srdB, cB + hstep + kstep, voffB);
        W();
        PG8_STAGE(PG8_SA(0, 0), srdA, cA, voffA); PG8_STAGE(PG8_SA(0, 1), srdA, cA + hstep, voffA);
        if (wr == 1) PG8_BAR;
        PG8_WAIT_V(2); PG8_BAR;
        PG8_WAIT_V(0); PG8_BAR;
    } else if constexpr (SP2) {
        PG8_STAGE(PG8_SB(0, 0), srdB, cB, voffB); PG8_STAGE(PG8_SB(0, 1), srdB, cB + hstep, voffB); PG8_STAGE(PG8_SA(0, 0), srdA, cA, voffA); PG8_STAGE(PG8_SA(0, 1), srdA, cA + hstep, voffA);
        if (wr == 1) PG8_BAR;
        PG8_WAIT_V(2); PG8_BAR;
        {
        PG8_STAGE(PG8_SB(1, 0), srdB, cB + kstep, voffB); PG8_STAGE(PG8_SA(1, 0), srdA, cA + kstep, voffA); PG8_STAGE(PG8_SB(1, 1), srdB, cB + hstep + kstep, voffB);
        PG8_WAIT_V(6); PG8_BAR; }
    } else {
        PG8_STAGE(PG8_SB(0, 0), srdB, cB, voffB); PG8_STAGE(PG8_SA(0, 0), srdA, cA, voffA); PG8_STAGE(PG8_SB(0, 1), srdB, cB + hstep, voffB); PG8_STAGE(PG8_SA(0, 1), srdA, cA + hstep, voffA);
        if (wr == 1) PG8_BAR;
        PG8_WAIT_V(4); PG8_BAR;
        PG8_STAGE(PG8_SB(1, 0), srdB, cB + kstep, voffB); PG8_STAGE(PG8_SA(1, 0), srdA, cA + kstep, voffA); PG8_STAGE(PG8_SB(1, 1), srdB, cB + hstep + kstep, voffB);
        PG8_WAIT_V(6); PG8_BAR;
    }
    for (;;) {
        const bool has_next = S.next(ui + 1, nxt);
        const unsigned nA = has_next ? (unsigned)(nxt.pm >> 3) * (unsigned)g.a_bstride + (unsigned)(nxt.pm & 7) * tstep + (unsigned)nxt.pn * (unsigned)g.a_pn_stride : cA, nB = has_next ? (unsigned)nxt.pn * tstep : cB;
        if constexpr (PIPE) { PG8_LDA(At, 0, 0); PG8_LDB(B0, 0, 0); PG8_LDB(B1, 0, 1); PG8_SCHED; }
#pragma clang loop unroll(disable)
        for (int t = 0; t < nt; t += 2) {
            const bool last = (t == nt - 2);
            const unsigned a1 = cA + (unsigned)(t + 1) * kstep;
            const unsigned a2 = last ? nA : cA + (unsigned)(t + 2) * kstep, b2 = last ? nB : cB + (unsigned)(t + 2) * kstep;
            const unsigned a3 = a2 + kstep, b3 = b2 + kstep;
            if (last && has_next) S.a_ready(nxt);
            if constexpr (PIPE) {
#define PG8_KT(b, pa, pb, rn) do { \
            PG8_LDA(Au, b, 1); PG8_SCHED; \
            PG8_MMA(0, 0, At, B0); PG8_SCHED; \
            PG8_WAIT_L(0); PG8_WAIT_V(0); PG8_BAR; PG8_SCHED; \
            if (wr == 0) { PG8_STAGE(PG8_SB(b, 0), srdB, (pb), voffB); PG8_STAGE(PG8_SB(b, 1), srdB, (pb) + hstep, voffB); } PG8_SCHED; \
            PG8_MMA(0, 1, At, B1); PG8_SCHED; \
            if (rn) PG8_LDA(At, (b) ^ 1, 0); \
            if (wr == 0) { PG8_STAGE(PG8_SA(b, 0), srdA, (pa), voffA); PG8_STAGE(PG8_SA(b, 1), srdA, (pa) + hstep, voffA); } else { PG8_STAGE(PG8_SB(b, 0), srdB, (pb), voffB); PG8_STAGE(PG8_SB(b, 1), srdB, (pb) + hstep, voffB); } PG8_SCHED; \
            PG8_MMA(1, 0, Au, B0); PG8_SCHED; \
            if (rn) PG8_LDB(B0, (b) ^ 1, 0); \
            if (wr == 1) { PG8_STAGE(PG8_SA(b, 0), srdA, (pa), voffA); PG8_STAGE(PG8_SA(b, 1), srdA, (pa) + hstep, voffA); } PG8_SCHED; \
            PG8_MMA(1, 1, Au, B1); PG8_SCHED; \
            if (rn) PG8_LDB(B1, (b) ^ 1, 1); PG8_SCHED; } while (0)
            PG8_KT(0, a2, b2, true);
            PG8_KT(1, a3, b3, !last);
#undef PG8_KT
            } else if constexpr (SP2 && MK_BAL != 0) {
            PG8_LDB(B0, 0, 0); PG8_LDB(B1, 0, 1); PG8_SCHED; PG8_LDA(At, 0, 0); PG8_STAGE(PG8_SA(1, 0), srdA, a1, voffA); PG8_STAGE(PG8_SA(1, 1), srdA, a1 + hstep, voffA);
            PG8_WAIT_V(8); PG8_WAIT_L(0); PG8_BAR; PG8_MMA(0, 0, At, B0); PG8_MMA(0, 1, At, B1); PG8_BAR; PG8_SCHED;
            PG8_LDA(At, 0, 1); PG8_STAGE(PG8_SB(0, 0), srdB, b2, voffB); PG8_STAGE(PG8_SB(0, 1), srdB, b2 + hstep, voffB);
            PG8_WAIT_V(6); PG8_WAIT_L(0); PG8_BAR; PG8_MMA(1, 0, At, B0); PG8_MMA(1, 1, At, B1); PG8_BAR; PG8_SCHED;
            PG8_LDB(B0, 1, 0); PG8_LDB(B1, 1, 1); PG8_SCHED; PG8_LDA(At, 1, 0); PG8_STAGE(PG8_SA(0, 0), srdA, a2, voffA); PG8_STAGE(PG8_SA(0, 1), srdA, a2 + hstep, voffA);
            PG8_WAIT_V(8); PG8_WAIT_L(0); PG8_BAR; PG8_MMA(0, 0, At, B0); PG8_MMA(0, 1, At, B1); PG8_BAR; PG8_SCHED;
            PG8_LDA(At, 1, 1); PG8_STAGE(PG8_SB(1, 0), srdB, b3, voffB); PG8_STAGE(PG8_SB(1, 1), srdB, b3 + hstep, voffB);
            PG8_WAIT_V(6); PG8_WAIT_L(0); PG8_BAR; PG8_MMA(1, 0, At, B0); PG8_MMA(1, 1, At, B1); PG8_BAR; PG8_SCHED;
            } else if constexpr (SP2) {
            const bool landed = MK_EPI_OVL && t == 0 && ui > 0;
            PG8_LDB(B0, 0, 0); PG8_LDB(B1, 0, 1); PG8_SCHED; PG8_LDA(At, 0, 0); PG8_STAGE(PG8_SA(1, 1), srdA, a1 + hstep, voffA);
            if (!landed) PG8_WAIT_V(8); PG8_WAIT_L(0); PG8_BAR; PG8_MMA(0, 0, At, B0); PG8_MMA(0, 1, At, B1); PG8_BAR; PG8_SCHED;
            PG8_LDA(At, 0, 1); PG8_STAGE(PG8_SB(0, 0), srdB, b2, voffB); PG8_STAGE(PG8_SB(0, 1), srdB, b2 + hstep, voffB); PG8_STAGE(PG8_SA(0, 0), srdA, a2, voffA);
            if (!landed) PG8_WAIT_V(8); PG8_WAIT_L(0); PG8_BAR; PG8_MMA(1, 0, At, B0); PG8_MMA(1, 1, At, B1); PG8_BAR; PG8_SCHED;
            PG8_LDB(B0, 1, 0); PG8_LDB(B1, 1, 1); PG8_SCHED; PG8_LDA(At, 1, 0); PG8_STAGE(PG8_SA(0, 1), srdA, a2 + hstep, voffA);
            if (!landed) PG8_WAIT_V(8); PG8_WAIT_L(0); PG8_BAR; PG8_MMA(0, 0, At, B0); PG8_MMA(0, 1, At, B1); PG8_BAR; PG8_SCHED;
            PG8_LDA(At, 1, 1); PG8_STAGE(PG8_SB(1, 0), srdB, b3, voffB); PG8_STAGE(PG8_SB(1, 1), srdB, b3 + hstep, voffB); PG8_STAGE(PG8_SA(1, 0), srdA, a3, voffA);
            PG8_WAIT_V(8); PG8_WAIT_L(0); PG8_BAR; PG8_MMA(1, 0, At, B0); PG8_MMA(1, 1, At, B1); PG8_BAR; PG8_SCHED;
            } else {
            PG8_LDB(B0, 0, 0); PG8_SCHED; PG8_LDA(At, 0, 0); PG8_STAGE(PG8_SA(1, 1), srdA, a1 + hstep, voffA);
            PG8_WAIT_L(8); PG8_BAR; PG8_WAIT_L(0); PG8_MMA(0, 0, At, B0); PG8_BAR; PG8_SCHED;
            PG8_LDB(B1, 0, 1); PG8_STAGE(PG8_SB(0, 0), srdB, b2, voffB);
            PG8_BAR; PG8_WAIT_L(0); PG8_MMA(0, 1, At, B1); PG8_BAR;
            PG8_LDA(At, 0, 1); PG8_STAGE(PG8_SA(0, 0), srdA, a2, voffA);
            PG8_BAR; PG8_WAIT_L(0); PG8_MMA(1, 0, At, B0); PG8_BAR; PG8_SCHED;
            PG8_STAGE(PG8_SB(0, 1), srdB, b2 + hstep, voffB);
            PG8_WAIT_V(6); PG8_BAR; PG8_MMA(1, 1, At, B1); PG8_BAR;
            PG8_LDB(B0, 1, 0); PG8_SCHED; PG8_LDA(At, 1, 0); PG8_STAGE(PG8_SA(0, 1), srdA, a2 + hstep, voffA);
            PG8_WAIT_L(8); PG8_BAR; PG8_WAIT_L(0); PG8_MMA(0, 0, At, B0); PG8_BAR; PG8_SCHED;
            PG8_LDB(B1, 1, 1); PG8_STAGE(PG8_SB(1, 0), srdB, b3, voffB);
            PG8_BAR; PG8_WAIT_L(0); PG8_MMA(0, 1, At, B1); PG8_BAR;
            PG8_LDA(At, 1, 1); PG8_STAGE(PG8_SA(1, 0), srdA, a3, voffA);
            PG8_BAR; PG8_WAIT_L(0); PG8_MMA(1, 0, At, B0); PG8_BAR; PG8_SCHED;
            PG8_STAGE(PG8_SB(1, 1), srdB, b3 + hstep, voffB);
            PG8_WAIT_V(6); PG8_BAR; PG8_MMA(1, 1, At, B1); PG8_BAR;
            }
        }
        if constexpr (ALIGN_EPI && !PIPE) { if (wr == 0) PG8_BAR; }
        if constexpr (SP2 && !PIPE && MK_EPI_OVL && MK_BAL == 0) { if (has_next) PG8_WAIT_V(0); }
        if constexpr (!Epi::AFTER_DRAIN) { if (!Sched::TWICE || (ui & 1)) { const int le = lane_now(); E(acc, cur, wr, wc, le & 15, le >> 4, wid * 64 + le, tab_pm); S.done(cur); } }
        if (!has_next) break;
#pragma unroll
        for (int a = 0; a < 2; ++a)
#pragma unroll
            for (int b = 0; b < 2; ++b)
#pragma unroll
                for (int m = 0; m < 4; ++m)
#pragma unroll
                    for (int n = 0; n < 2; ++n) acc[a][b][m][n] = (f32x4){0.f, 0.f, 0.f, 0.f};
        cur = nxt; cA = nA; cB = nB; ++ui;
        if constexpr (ALIGN_EPI && !PIPE) { if (wr == 1) PG8_BAR; }
    }
    PG8_WAIT_V(0);
    if constexpr (!ALIGN_EPI && !PIPE) { if (wr == 0) PG8_BAR; }
    PG8_BAR;
#undef PG8_SA
#undef PG8_SB
#undef PG8_STAGE
#undef PG8_STAGE4
#undef PG8_LDA
#undef PG8_LDA1
#undef PG8_LDB
#undef PG8_MMA
#undef PG8_WAIT_V
#undef PG8_WAIT_L
#undef PG8_BAR
#undef PG8_SCHED
}

struct PoolSrc { const bf16_t* hb; const float* ss; };
__device__ __forceinline__ void pool_issue(unsigned (&x)[31], const __amdgpu_buffer_rsrc_t srd, unsigned soff, unsigned loff, bool above_zero) {
#pragma unroll
    for (int i = 0; i < 31; ++i) { unsigned v = __builtin_amdgcn_raw_buffer_load_b32(srd, (int)loff, (int)(soff + (unsigned)i * 2048u), 0); if (i < 15 && above_zero) v = 0u; x[i] = v; }
}
template <int W> __device__ __forceinline__ void pool_finish(const unsigned (&x)[31], const PG8_LAS float* tabr, PG8_LAS unsigned char* alo, PG8_LAS unsigned char* ahi, int R0, unsigned azv) {
    asm volatile("" : "+v"(azv)); const bool az = azv != 0u;
    typedef float f32x2 __attribute__((ext_vector_type(2)));
    const PG8_LAS float* tr = tabr + 16 + R0 - (W - 1);
#define PGF_HN(i) ((f32x2){__uint_as_float(x[16 - W + (i)] << 16), __uint_as_float(x[16 - W + (i)] & 0xffff0000u)} * tr[(i)])
    f32x2 win[W];
    f32x2 S = {0.f, 0.f};
#pragma unroll
    for (int i = 0; i < W; ++i) { win[i] = PGF_HN(i); S += win[i]; }
#pragma unroll
    for (int r = 0; r < 16; ++r) { const float inv = (r + 1 < W && az) ? 1.0f / (float)(r + 1) : 1.0f / (float)W;
        const f32x2 p = S * inv - win[(W - 1 + r) % W];
        *(PG8_LAS unsigned*)((r < 8 ? alo : ahi) + (r & 7) * 64) = cvt_pk_bf16(p.x, p.y);
        if (r < 15) { const f32x2 nw = PGF_HN(W + r); S += nw - win[r % W]; win[r % W] = nw; } }
#undef PGF_HN
}
template <class Epi, class Sched, class Seam>
__device__ __forceinline__ void pool_gemm_phase(PG8_LAS unsigned char* lds, const bf16_t* Bt, const PoolSrc ps, const Sched& S, const Epi& E, const int tid, const Seam& W) {
    const int wid = __builtin_amdgcn_readfirstlane(tid >> 6), lane = tid & 63, wr = wid >> 2, wc = wid & 3, fr = lane & 15, fq = lane >> 4;
    constexpr int K = 256;
    unsigned voffB[2];
#pragma unroll
    for (int i = 0; i < 2; ++i) { int R, C; stage_rc(tid * 16 + i * 8192, R, C); const int Rb = (R & ~31) + perm32(R & 31); voffB[i] = (unsigned)(Rb * K + C) * 2u; }
    const unsigned kstep = (unsigned)(BK * 2), hstep = (unsigned)(HALF * K * 2), tstep = 2 * hstep;
    const unsigned ldsw = (unsigned)wid * 1024u;
    const int aoff = lds_byte(wr * 64 + fr, fq * 8), boff = lds_byte(wc * 32 + fr, fq * 8);
    PG8_LAS float* const tabr = (PG8_LAS float*)(lds + STAGE_BYTES + 2048);
#define PGF_SA(b, h) (((b) * 2 + (h)) * HTB)
#define PGF_SB(b, h) ((4 + (b) * 2 + (h)) * HTB)
#define PGF_STAGE(bufoff, soff) do { _Pragma("unroll") for (int _i = 0; _i < 2; ++_i) \
        __builtin_amdgcn_raw_ptr_buffer_load_lds(srdB, (PG8_LAS unsigned*)(lds + (bufoff) + ldsw + _i * 8192), 16, voffB[_i], (soff), 0, 0); } while (0)
    const __amdgpu_buffer_rsrc_t srdB = __builtin_amdgcn_make_buffer_rsrc((void*)Bt, (short)0, 0x7fffffff, 0x00020000);
    const __amdgpu_buffer_rsrc_t srdH = __builtin_amdgcn_make_buffer_rsrc((void*)(ps.hb - 16 * 1024), (short)0, 0x7fffffff, 0x00020000);
    const int cp = tid & 31, R0 = (tid >> 5) * 16;
    const int stA = ((R0 >> 4) & 7) * 2 + (cp >> 4), hA = R0 >> 7, cb = (cp & 15) * 4;
    Unit cur; f32x4 acc[2][2][4][2]; bf16x8 At[4][2], B0[2][2]; int tab_pm = -1;
#pragma unroll 1
    for (int ui = 0; S.next(ui, cur); ++ui) {
        const int g = cur.pn, P = cur.pm, sq = (P & 7) * 256; const bool zero_above = (P & 7) == 0;
        const unsigned cB = (unsigned)g * tstep;
        PGF_STAGE(PGF_SB(0, 0), cB); PGF_STAGE(PGF_SB(0, 1), cB + hstep);
        if (ui == 0) W();
        int tq = tid; asm volatile("" : "+v"(tq));
        const bool trow = tq < 272 && !(tq < 16 && zero_above);
        f32x4 p0 = {0.f, 0.f, 0.f, 0.f}, p1 = p0, p2 = p0, p3 = p0;
        if (trow) { const f32x4* p = (const f32x4*)(ps.ss + (size_t)(P * BM + tq - 16) * 16); p0 = p[0]; p1 = p[1]; p2 = p[2]; p3 = p[3]; }
        __builtin_amdgcn_sched_barrier(0);
        const unsigned ub0 = (unsigned)((P * BM + 1) * 2048 + g * 512);
        const unsigned loff = (unsigned)(R0 * 2048 + 4 * cp); const bool above_zero = zero_above && R0 == 0; const unsigned azv = above_zero ? 1u : 0u;
        unsigned x[31];
        pool_issue(x, srdH, ub0, loff, above_zero);
        __builtin_amdgcn_sched_barrier(0);
        if (tq < 272) { float r = 0.f;
            if (trow) { const float t = ((p0[0] + p0[1]) + (p0[2] + p0[3])) + ((p1[0] + p1[1]) + (p1[2] + p1[3])) + ((p2[0] + p2[1]) + (p2[2] + p2[3])) + ((p3[0] + p3[1]) + (p3[2] + p3[3]));
                r = rsqrtf(t * (1.0f / 1024.0f) + RMS_EPS); }
            tabr[tq] = r; }
        asm volatile("s_waitcnt lgkmcnt(0)" ::: "memory"); __builtin_amdgcn_s_barrier(); asm volatile("" ::: "memory");
#define PGF_FIN(bb) do { PG8_LAS unsigned char* ab = lds + PGF_SA((bb), hA) + stA * 1024; \
          PG8_LAS unsigned char* alo = ab + cb, * ahi = ab + 512 + (cb ^ 32);                        \
          if (g == 0) pool_finish<2>(x, tabr, alo, ahi, R0, azv); else if (g == 1) pool_finish<4>(x, tabr, alo, ahi, R0, azv); else if (g == 2) pool_finish<8>(x, tabr, alo, ahi, R0, azv); else pool_finish<16>(x, tabr, alo, ahi, R0, azv); } while (0)
#define PGF_MMA(bb) do { _Pragma("unroll") for (int ai = 0; ai < 2; ++ai) { \
                _Pragma("unroll") for (int m = 0; m < 4; ++m) _Pragma("unroll") for (int k = 0; k < 2; ++k) At[m][k] = *(const PG8_LAS bf16x8*)(lds + PGF_SA((bb), ai) + aoff + m * 2048 + k * 1024); \
                _Pragma("unroll") for (int bj = 0; bj < 2; ++bj) { \
                    _Pragma("unroll") for (int n = 0; n < 2; ++n) _Pragma("unroll") for (int k = 0; k < 2; ++k) B0[n][k] = *(const PG8_LAS bf16x8*)(lds + PGF_SB((bb), bj) + boff + n * 2048 + k * 1024); \
                    __builtin_amdgcn_s_setprio(1); \
                    _Pragma("unroll") for (int m = 0; m < 4; ++m) _Pragma("unroll") for (int n = 0; n < 2; ++n) _Pragma("unroll") for (int k = 0; k < 2; ++k) \
                        acc[ai][bj][m][n] = __builtin_amdgcn_mfma_f32_16x16x32_bf16(B0[n][k], At[m][k], acc[ai][bj][m][n], 0, 0, 0); \
                    __builtin_amdgcn_s_setprio(0); } } } while (0)
        PGF_FIN(0);
        if (wr == 1) pool_issue(x, srdH, ub0 + 128u, loff, above_zero);
        __builtin_amdgcn_sched_barrier(0);
#pragma unroll
        for (int a = 0; a < 2; ++a)
#pragma unroll
            for (int b = 0; b < 2; ++b)
#pragma unroll
                for (int m = 0; m < 4; ++m)
#pragma unroll
                    for (int n = 0; n < 2; ++n) acc[a][b][m][n] = (f32x4){0.f, 0.f, 0.f, 0.f};
#pragma unroll 1
        for (int kt = 0; kt < 4; ++kt) { const int b = kt & 1;
            asm volatile("s_waitcnt lgkmcnt(0)" ::: "memory"); if (wr == 0 || kt == 3) asm volatile("s_waitcnt vmcnt(0)" ::: "memory"); else asm volatile("s_waitcnt vmcnt(31)" ::: "memory");
            __builtin_amdgcn_s_barrier(); asm volatile("" ::: "memory");
            if (kt < 3) { PGF_STAGE(PGF_SB(b ^ 1, 0), cB + (unsigned)(kt + 1) * kstep); PGF_STAGE(PGF_SB(b ^ 1, 1), cB + hstep + (unsigned)(kt + 1) * kstep); }
            if (wr == 1 && kt < 3) PGF_FIN(b ^ 1);
            if (kt + wr < 3) pool_issue(x, srdH, ub0 + 128u * (unsigned)(kt + 1 + wr), loff, above_zero);
            __builtin_amdgcn_sched_barrier(0);
            PGF_MMA(b);
            __builtin_amdgcn_sched_barrier(0);
            if (wr == 0 && kt < 3) PGF_FIN(b ^ 1);
        }
#undef PGF_FIN
#undef PGF_MMA
        { const int le = lane_now(); E(acc, cur, wr, wc, le & 15, le >> 4, wid * 64 + le, tab_pm); }
        asm volatile("s_waitcnt vmcnt(0) lgkmcnt(0)" ::: "memory"); __builtin_amdgcn_s_barrier(); asm volatile("" ::: "memory");
    }
#undef PGF_SA
#undef PGF_SB
#undef PGF_STAGE
}
}

constexpr int NWAVES = 8;
constexpr int BATCH = 8, SEQ = 2048, D = 1024, FF = 4096, DEPTH = 4, CW = 31, NG = 4, GW = 256;
constexpr int M = BATCH * SEQ;
constexpr float LN_EPS = 1e-6f;

constexpr size_t MiB = 1u << 20;
constexpr size_t WS_CTL = 0, CTL_ZERO_BYTES = 64 * 1024;
constexpr size_t WS_SS = 1 * MiB;
constexpr size_t WS_WC1 = 10 * MiB;
constexpr size_t WS_WC2 = 18 * MiB;
constexpr size_t WS_WP = 22 * MiB;
constexpr size_t WS_WM1 = 23 * MiB;
constexpr size_t WS_WM2 = 55 * MiB;
constexpr size_t WS_HB = 87 * MiB;
constexpr size_t WS_T = 119 * MiB;
constexpr size_t SLAB = 16 * MiB;
constexpr size_t WS_U = WS_T, WS_V = WS_T + 4 * MiB, WS_P = WS_T + 8 * MiB;
constexpr size_t WS_END = 247 * MiB;
constexpr size_t OUT_HB2 = 64 * 1024;
constexpr int CW_BAR = 1024;

constexpr int RING_OFF = 0, RING_BYTES = 131072;
constexpr int LDSCTL_OFF = RING_BYTES, MISC_OFF = LDSCTL_OFF + 320;
constexpr int LDS_BYTES = 147456;

#define GAS __attribute__((address_space(1)))
#define LAS __attribute__((address_space(3)))
typedef unsigned short bf16;
typedef unsigned v4u __attribute__((ext_vector_type(4)));
typedef unsigned v2u __attribute__((ext_vector_type(2)));
typedef float f32x4 __attribute__((ext_vector_type(4)));
typedef GAS unsigned gu32;
#define RLX_AGENT __ATOMIC_RELAXED, __HIP_MEMORY_SCOPE_AGENT
#define LDS_WAIT() asm volatile("s_waitcnt lgkmcnt(0)" ::: "memory")
#define VM_WAIT() asm volatile("s_waitcnt vmcnt(0)" ::: "memory")
__device__ __forceinline__ unsigned pk2(float lo, float hi) { return pg8::cvt_pk_bf16(lo, hi); }
__device__ __forceinline__ float bflo(unsigned u) { return __uint_as_float(u << 16); }
__device__ __forceinline__ float bfhi(unsigned u) { return __uint_as_float(u & 0xffff0000u); }

#define XB_TMO      128
#define XB_XCNT(j)  (256  + 64 * (j))
#define XB_XSUB(j)  (1280 + 64 * (j))
#define XB_XGEN(j)  (2304 + 64 * (j))
#define XB_TOP      3328
#define XB_TOPGEN   3392
#define XCD_BAR_WORDS 3456
#define XB_SPIN_CAP (1u << 18)
__device__ __forceinline__ unsigned xb_ld(unsigned* p)              { return __hip_atomic_load(p, __ATOMIC_RELAXED, __HIP_MEMORY_SCOPE_AGENT); }
__device__ __forceinline__ unsigned xb_add(unsigned* p, unsigned v) { return __hip_atomic_fetch_add(p, v, __ATOMIC_RELAXED, __HIP_MEMORY_SCOPE_AGENT); }
__device__ __forceinline__ unsigned xb_xcc_id() { return (unsigned)__builtin_amdgcn_s_getreg((3 << 11) | 20) & 0xFu; }
#define XB_SPIN(cond, bar) do { unsigned _sp = 0; while (cond) { __builtin_amdgcn_s_sleep(16); \
    if ((++_sp & 255u) == 0u) { if (xb_ld(&(bar)[XB_TMO])) break; if (_sp > XB_SPIN_CAP) { atomicAdd(&(bar)[XB_TMO], 1u); break; } } } } while (0)
struct XcdBarrier { unsigned* bar; unsigned x; volatile LAS unsigned* st; };
__device__ __forceinline__ XcdBarrier xcd_barrier_post(unsigned* bar, volatile LAS unsigned* st) {
    XcdBarrier b; b.bar = bar; b.x = xb_xcc_id(); b.st = st;
    if (threadIdx.x == 0) (void)xb_add(&bar[XB_XCNT(b.x)], 1u);
    return b;
}
__device__ __forceinline__ void xcd_barrier_complete(unsigned* bar, unsigned x, unsigned& nloc, unsigned& nx) {
    const unsigned G = gridDim.x * gridDim.y * gridDim.z;
    unsigned sum, cnt, mine, sp = 0u;
    for (;;) {
        sum = 0u; cnt = 0u; mine = 0u;
#pragma unroll
        for (unsigned j = 0; j < 16; ++j) { const unsigned c = xb_ld(&bar[XB_XCNT(j)]); sum += c; cnt += (c > 0u) ? 1u : 0u; mine = (j == x) ? c : mine; }
        if (sum == G) break;
        __builtin_amdgcn_s_sleep(1);
        if ((++sp & 255u) == 0u) { if (xb_ld(&bar[XB_TMO])) break; if (sp > XB_SPIN_CAP) { atomicAdd(&bar[XB_TMO], 1u); break; } }
    }
    nloc = mine > 0u ? mine : 1u; nx = cnt > 0u ? cnt : 1u;
}
__device__ __forceinline__ void xcd_barrier(const XcdBarrier& b, bool t0) {
    asm volatile("s_waitcnt vmcnt(0)" ::: "memory");
    __syncthreads();
    if (t0) {
        unsigned* bar = b.bar;
        __builtin_amdgcn_s_waitcnt(0);
        unsigned nloc = b.st[0], nx = b.st[1];
        if (nloc == 0u) { xcd_barrier_complete(bar, b.x, nloc, nx); b.st[0] = nloc; b.st[1] = nx; }
        const unsigned old = xb_add(&bar[XB_XSUB(b.x)], 1u);
        const unsigned gen = old / nloc;
        if (old + 1u == (gen + 1u) * nloc) {
            __builtin_amdgcn_fence(__ATOMIC_RELEASE, "agent");
            asm volatile("s_waitcnt vmcnt(0)" ::: "memory");
            const unsigned og = xb_add(&bar[XB_TOP], 1u);
            const unsigned tg = og / nx;
            if (og + 1u == (tg + 1u) * nx) xb_add(&bar[XB_TOPGEN], 1u);
            else XB_SPIN(xb_ld(&bar[XB_TOPGEN]) == tg, bar);
            __builtin_amdgcn_fence(__ATOMIC_ACQUIRE, "agent");
            xb_add(&bar[XB_XGEN(b.x)], 1u);
            asm volatile("s_waitcnt vmcnt(0)" ::: "memory");
        } else {
            XB_SPIN(xb_ld(&bar[XB_XGEN(b.x)]) == gen, bar);
            __builtin_amdgcn_fence(__ATOMIC_ACQUIRE, "agent");
            asm volatile("s_waitcnt vmcnt(0)" ::: "memory");
        }
    }
    __syncthreads();
}
struct EpiFinal {
    static constexpr bool PERM = true, AFTER_DRAIN = false;
    const pg8::bf16_t* hin; float* ss; const float* gain; float* out; PG8_LAS float* tab; XcdBarrier bar;
    __device__ __forceinline__ void operator()(const pg8::f32x4 (&acc_)[2][2][4][2], const pg8::Unit& u, int wr, int wc, int fr, int fq, int tid, int& tab_pm) const {
        using pg8::f32x4; using pg8::u32x4; constexpr int HALF = pg8::HALF, BM = pg8::BM;
        f32x4 (&v)[2][2][4][2] = const_cast<f32x4 (&)[2][2][4][2]>(acc_);
        const int row0 = u.pm * BM + wr * 64 + fr, col0 = u.pn * BM + wc * 32 + 8 * fq;
        constexpr int DEPTH = MK_EPI_DEPTH;
        u32x4 pre[8][2];
#pragma unroll
        for (int g = 0; g < DEPTH; ++g)
#pragma unroll
            for (int bj = 0; bj < 2; ++bj) pre[g][bj] = *(const u32x4*)(hin + (size_t)(row0 + (g >> 2) * HALF + (g & 3) * 16) * 1024 + col0 + bj * HALF);
#pragma unroll
        for (int g = 0; g < 8; ++g) { const int ai = g >> 2, m = g & 3; const int row = row0 + ai * HALF + m * 16; float q = 0.f;
            if (g + DEPTH < 8) {
#pragma unroll
                for (int bj = 0; bj < 2; ++bj) pre[g + DEPTH][bj] = *(const u32x4*)(hin + (size_t)(row0 + ((g + DEPTH) >> 2) * HALF + ((g + DEPTH) & 3) * 16) * 1024 + col0 + bj * HALF); }
#pragma unroll
            for (int bj = 0; bj < 2; ++bj) { const u32x4 o = pre[g][bj];
                const f32x4 r0 = {__uint_as_float(o.x << 16), __uint_as_float(o.x & 0xffff0000u), __uint_as_float(o.y << 16), __uint_as_float(o.y & 0xffff0000u)};
                const f32x4 r1 = {__uint_as_float(o.z << 16), __uint_as_float(o.z & 0xffff0000u), __uint_as_float(o.w << 16), __uint_as_float(o.w & 0xffff0000u)};
                const f32x4 v0 = r0 + v[ai][bj][m][0], v1 = r1 + v[ai][bj][m][1]; v[ai][bj][m][0] = v0; v[ai][bj][m][1] = v1;
                q += (v0[0] * v0[0] + v0[1] * v0[1]) + (v0[2] * v0[2] + v0[3] * v0[3]) + (v1[0] * v1[0] + v1[1] * v1[1]) + (v1[2] * v1[2] + v1[3] * v1[3]); }
            q += __shfl_xor(q, 16); q += __shfl_xor(q, 32);
            if (fq == 0) ss[(size_t)row * 16 + u.pn * 4 + wc] = q; }
        xcd_barrier(bar, tid == 0);
        float rs[2][4]; pg8::rows_rstd(ss, u.pm, tab, wr, fr, tid, true, rs); tab_pm = -1;
        f32x4 gv[2][2];
#pragma unroll
        for (int bj = 0; bj < 2; ++bj)
#pragma unroll
            for (int n = 0; n < 2; ++n) gv[bj][n] = *(const f32x4*)(gain + col0 + bj * HALF + 4 * n);
#pragma unroll
        for (int ai = 0; ai < 2; ++ai)
#pragma unroll
            for (int m = 0; m < 4; ++m) { const float r = rs[ai][m]; float* op = out + (size_t)(row0 + ai * HALF + m * 16) * 1024 + col0;
#pragma unroll
                for (int bj = 0; bj < 2; ++bj) { *(f32x4*)(op + bj * HALF) = v[ai][bj][m][0] * r * gv[bj][0]; *(f32x4*)(op + bj * HALF + 4) = v[ai][bj][m][1] * r * gv[bj][1]; } }
    }
};

constexpr int CW_XCC = 8192;
constexpr int CW_GRP = 8192 + 512;
constexpr int CW_GTMO = 8192 + 512 + 64 * 8;
__device__ __forceinline__ void group_barrier(unsigned* ctl, int gx, int ng, bool same_xcd, bool t0) {
    asm volatile("s_waitcnt vmcnt(0)" ::: "memory");
    __syncthreads();
    if (t0) {
        if (!same_xcd) { __builtin_amdgcn_fence(__ATOMIC_RELEASE, "agent"); }
        asm volatile("s_waitcnt vmcnt(0)" ::: "memory");
        unsigned* cnt = ctl + CW_GRP + 64 * gx;
        const unsigned old = xb_add(cnt, 1u);
        const unsigned target = (old / (unsigned)ng + 1u) * (unsigned)ng;
        unsigned sp = 0u;
        while (xb_ld(cnt) < target) {
            if ((++sp & 255u) == 0u) { if (xb_ld(ctl + CW_GTMO)) break; if (sp > XB_SPIN_CAP) { atomicAdd(ctl + CW_GTMO, 1u); break; } } }
        __builtin_amdgcn_fence(__ATOMIC_ACQUIRE, "agent");
        asm volatile("s_waitcnt vmcnt(0)" ::: "memory");
    }
    __syncthreads();
}
__device__ __forceinline__ void group_arrive(unsigned* ctl, int gx, int ng, bool same_xcd, bool t0, volatile LAS unsigned* tgt) {
    asm volatile("s_waitcnt vmcnt(0)" ::: "memory");
    __syncthreads();
    if (t0) {
        if (!same_xcd) { __builtin_amdgcn_fence(__ATOMIC_RELEASE, "agent"); }
        asm volatile("s_waitcnt vmcnt(0)" ::: "memory");
        if (same_xcd) { __builtin_amdgcn_fence(__ATOMIC_ACQUIRE, "agent"); }
        const unsigned old = xb_add(ctl + CW_GRP + 64 * gx, 1u);
        const unsigned target = (old / (unsigned)ng + 1u) * (unsigned)ng;
        tgt[0] = target; tgt[1] = (old + 1u == target) ? 1u : 0u; tgt[2] = same_xcd ? 1u : 0u;
    }
}
__device__ __forceinline__ void group_wait(unsigned* ctl, int gx, bool t0, volatile LAS unsigned* tgt) {
    if (t0) {
        unsigned* cnt = ctl + CW_GRP + 64 * gx;
        const unsigned target = tgt[0];
        if (tgt[1] == 0u) { unsigned sp = 0u;
            while (xb_ld(cnt) < target) {
                if ((++sp & 255u) == 0u) { if (xb_ld(ctl + CW_GTMO)) break; if (sp > XB_SPIN_CAP) { atomicAdd(ctl + CW_GTMO, 1u); break; } } } }
        if (tgt[2] == 0u) __builtin_amdgcn_fence(__ATOMIC_ACQUIRE, "agent");
        asm volatile("s_waitcnt vmcnt(0)" ::: "memory");
    }
    asm volatile("s_waitcnt lgkmcnt(0)" ::: "memory"); __builtin_amdgcn_s_barrier(); asm volatile("" ::: "memory");
}
struct SeamWait {
    unsigned* ctl; int gx; volatile LAS unsigned* tgt; bool pending; int wave;
    __device__ __forceinline__ void operator()() const { if (pending) group_wait(ctl, gx, wave == 0 && pg8::lane_now() == 0, tgt); }
};

struct Args { const float* in[17]; float* out; unsigned char* ws; int ph_lo, ph_hi; };
typedef const __attribute__((address_space(4))) Args CArgs;
struct Frame {
    LAS unsigned char* lds;
    int tid, lane, wave, vcu, G;
    int gx, gj, ng, grouped;
};
__device__ __forceinline__ float wave_sum(float v) {
#pragma unroll
    for (int o = 1; o < 64; o <<= 1) v += __shfl_xor(v, o);
    return v;
}

struct P0Job { const float* W; const float* gk; const float* sn; bf16* WT; int ldw, K, drow0; };
__device__ __forceinline__ P0Job p0_decode(CArgs* ap, int it) {
    constexpr int I_C1 = 16 * 64, I_C2 = 16 * 32, I_P = 4 * 8, I_M1 = 16 * 128, I_M2 = 64 * 32;
    constexpr int E_C1 = 2 * I_C1, E_C2 = E_C1 + 2 * I_C2, E_P = E_C2 + 8 * I_P, E_M1 = E_P + 4 * I_M1;
    unsigned char* ws = ap->ws; P0Job j; j.gk = nullptr; j.sn = nullptr;
    if (it < E_C1) { const int l = it / I_C1, r = it % I_C1, kb = r / 64, nb = r % 64, n0 = 32 * nb, k0 = 64 * kb;
        const int bj = n0 >> 10, rem = n0 & 1023; j.drow0 = 256 * (rem >> 7) + 128 * bj + (rem & 127); j.ldw = 2 * D; j.K = D;
        j.W = ap->in[3] + (size_t)l * D * 2 * D + (size_t)k0 * (2 * D) + n0; j.gk = ap->in[1] + (2 * l) * D + k0; j.WT = (bf16*)(ws + WS_WC1) + (size_t)l * 2 * D * D + k0; }
    else if (it < E_C2) { const int q = it - E_C1, l = q / I_C2, r = q % I_C2, k0 = 64 * (r / 32), n0 = 32 * (r % 32); j.drow0 = n0; j.ldw = D; j.K = D;
        j.W = ap->in[9] + (size_t)l * D * D + (size_t)k0 * D + n0; j.WT = (bf16*)(ws + WS_WC2) + (size_t)l * D * D + k0; }
    else if (it < E_P) { const int q = it - E_C2, lg = q / I_P, l = lg >> 2, g = lg & 3, r = q % I_P, k0 = 64 * (r / 8), n0 = 32 * (r % 8); j.drow0 = g * GW + n0; j.ldw = GW; j.K = GW;
        j.W = ap->in[11] + (size_t)lg * GW * GW + (size_t)k0 * GW + n0; j.gk = ap->in[1] + (2 * l + 1) * D + g * GW + k0; j.sn = ap->in[13] + l * D + g * GW + n0; j.WT = (bf16*)(ws + WS_WP) + (size_t)l * D * GW + k0; }
    else if (it < E_M1) { const int q = it - E_P, l = q / I_M1, r = q % I_M1, k0 = 64 * (r / 128), n0 = 32 * (r % 128); j.drow0 = n0; j.ldw = FF; j.K = D;
        j.W = ap->in[14] + (size_t)l * D * FF + (size_t)k0 * FF + n0; j.gk = ap->in[2] + l * D + k0; j.WT = (bf16*)(ws + WS_WM1) + (size_t)l * D * FF + k0; }
    else { const int q = it - E_M1, l = q / I_M2, r = q % I_M2, k0 = 64 * (r / 32), n0 = 32 * (r % 32); j.drow0 = n0; j.ldw = D; j.K = FF;
        j.W = ap->in[15] + (size_t)l * D * FF + (size_t)k0 * D + n0; j.WT = (bf16*)(ws + WS_WM2) + (size_t)l * D * FF + k0; }
    return j;
}
__device__ __forceinline__ void p0_load(const P0Job& j, float (&v)[32], int lane) {
    const float* p = j.W + (size_t)(lane >> 5) * j.ldw + (lane & 31);
#pragma unroll
    for (int i = 0; i < 32; ++i) v[i] = p[(size_t)(2 * i) * j.ldw];
}
__device__ __forceinline__ void p0_finish(const P0Job& j, const float (&v)[32], LAS float* scr, int lane) {
#pragma unroll
    for (int i = 0; i < 32; ++i) scr[(2 * i + (lane >> 5)) * 33 + (lane & 31)] = v[i];
    const int c = lane & 7;
    f32x4 g0 = {1.f, 1.f, 1.f, 1.f}, g1 = g0;
    if (j.gk) { g0 = *(const f32x4*)(j.gk + 8 * c); g1 = *(const f32x4*)(j.gk + 8 * c + 4); }
    LDS_WAIT(); asm volatile("" ::: "memory");
#pragma unroll
    for (int jj = 0; jj < 4; ++jj) { const int n = (lane >> 3) + 8 * jj; const LAS float* s = scr + (8 * c) * 33 + n; const float sc = j.sn ? j.sn[n] : 1.0f;
        v4u o; o.x = pk2(s[0 * 33] * g0.x * sc, s[1 * 33] * g0.y * sc); o.y = pk2(s[2 * 33] * g0.z * sc, s[3 * 33] * g0.w * sc); o.z = pk2(s[4 * 33] * g1.x * sc, s[5 * 33] * g1.y * sc); o.w = pk2(s[6 * 33] * g1.z * sc, s[7 * 33] * g1.w * sc);
        *(GAS v4u*)(j.WT + (size_t)(j.drow0 + n) * j.K + 8 * c) = o; }
    LDS_WAIT(); asm volatile("" ::: "memory");
}
constexpr int P0_NITEMS = 2 * 16 * 64 + 2 * 16 * 32 + 8 * 4 * 8 + 4 * 16 * 128 + 4 * 64 * 32, P0_FIRST = 16 * 64;
__device__ __forceinline__ void p0_items(const Frame& F, CArgs* ap, int first, int last, int st) {
    LAS float* scr = (LAS float*)(F.lds + RING_OFF + F.wave * 16384);
    if (first < last) {
        float vc[32], vn[32];
        P0Job job = p0_decode(ap, first); p0_load(job, vc, F.lane);
        for (int it = first; it < last; it += st) {
            const int itn = (it + st < last) ? it + st : it;
            const P0Job jobn = p0_decode(ap, itn); p0_load(jobn, vn, F.lane);
            __builtin_amdgcn_sched_barrier(0);
            p0_finish(job, vc, scr, F.lane);
            job = jobn;
#pragma unroll
            for (int i = 0; i < 32; ++i) vc[i] = vn[i];
        }
    }
}
__device__ __forceinline__ void p0a_phase(const Frame& F, CArgs* ap) {
    const int gw = F.vcu * NWAVES + F.wave, NGW = F.G * NWAVES;
    { const float* x = ap->in[0]; bf16* hb = (bf16*)(ap->ws + WS_HB); float* ss0 = (float*)(ap->ws + WS_SS);
      const int mb = F.grouped ? SEQ * F.gx : 0, ms = F.grouped ? 2 * (F.gj * NWAVES + F.wave) : 2 * gw, mst = F.grouped ? 2 * F.ng * NWAVES : 2 * NGW, mc = F.grouped ? SEQ : M;
      for (int ml = ms; ml < mc; ml += mst) { const int m = mb + ml;
        const GAS f32x4* xr = (const GAS f32x4*)(x + (size_t)m * D) + F.lane;
        f32x4 v[8];
#pragma unroll
        for (int j = 0; j < 8; ++j) v[j] = xr[64 * j];
        float s0 = 0.f, s1 = 0.f;
#pragma unroll
        for (int j = 0; j < 4; ++j) { s0 += (v[j].x * v[j].x + v[j].y * v[j].y) + (v[j].z * v[j].z + v[j].w * v[j].w); s1 += (v[4 + j].x * v[4 + j].x + v[4 + j].y * v[4 + j].y) + (v[4 + j].z * v[4 + j].z + v[4 + j].w * v[4 + j].w); }
        s0 = wave_sum(s0); s1 = wave_sum(s1);
        GAS v2u* o8 = (GAS v2u*)(hb + (size_t)m * D) + F.lane;
#pragma unroll
        for (int j = 0; j < 8; ++j) { v2u w; w.x = pk2(v[j].x, v[j].y); w.y = pk2(v[j].z, v[j].w); o8[64 * j] = w; }
        if (F.lane < 32) ss0[(size_t)m * 16 + F.lane] = (F.lane == 0) ? s0 : (F.lane == 16 ? s1 : 0.f);
      } }
    p0_items(F, ap, gw, P0_FIRST, NGW);
}
constexpr int CW_WDONE = 8192 + 512 + 64 * 9;
__device__ __forceinline__ void p0b_phase(const Frame& F, CArgs* ap) {
    constexpr int NB = P0_NITEMS - P0_FIRST;
    if (F.grouped) {
#if MK_SHARE == 0
        const int c0 = F.gx * F.gx, c1 = (F.gx + 1) * (F.gx + 1), ct = 64;
#elif MK_SHARE == 1
        const int c0 = F.gx * (F.gx - 1) / 2, c1 = F.gx * (F.gx + 1) / 2, ct = 28;
#elif MK_SHARE == 2
        const int c0 = (F.gx - 1) * F.gx * (2 * F.gx - 1) / 6, c1 = F.gx * (F.gx + 1) * (2 * F.gx + 1) / 6, ct = 140;
#else
        const int c0 = F.gx * F.gx + 2 * F.gx, c1 = (F.gx + 1) * (F.gx + 1) + 2 * (F.gx + 1), ct = 80;
#endif
        const int i0 = P0_FIRST + (int)(((long)NB * c0) / ct), i1 = P0_FIRST + (int)(((long)NB * c1) / ct);
        p0_items(F, ap, i0 + F.gj * NWAVES + F.wave, i1, F.ng * NWAVES); }
    else p0_items(F, ap, P0_FIRST + F.vcu * NWAVES + F.wave, P0_NITEMS, F.G * NWAVES);
    VM_WAIT(); __syncthreads();
    if (F.tid == 0) { __builtin_amdgcn_fence(__ATOMIC_RELEASE, "agent"); asm volatile("s_waitcnt vmcnt(0)" ::: "memory"); xb_add((unsigned*)(ap->ws + WS_CTL) + CW_WDONE, 1u); }
}
constexpr int CW_W0DONE = 8192 + 512 + 64 * 11;
__device__ __forceinline__ void wait_weights(unsigned* ctl, volatile LAS unsigned* wst, unsigned G, bool t0, int cw = CW_WDONE) {
    if (wst[0] == 0u) {
        if (t0) { unsigned sp = 0u;
            while (xb_ld(ctl + cw) < G) { __builtin_amdgcn_s_sleep(2); if ((++sp & 255u) == 0u) { if (xb_ld(ctl + CW_GTMO)) break; if (sp > XB_SPIN_CAP) { atomicAdd(ctl + CW_GTMO, 1u); break; } } }
            __builtin_amdgcn_fence(__ATOMIC_ACQUIRE, "agent"); asm volatile("s_waitcnt vmcnt(0)" ::: "memory");
            wst[0] = 1u; }
        __syncthreads();
    }
}

__device__ __forceinline__ float wave_reduce32(float (&v)[32], int lane) {
#define WR_STEP(NN, BIT) { const bool hi = (lane & (BIT)) != 0; _Pragma("unroll") for (int i = 0; i < (NN); ++i) { const float send = hi ? v[i] : v[i + (NN)], keep = hi ? v[i + (NN)] : v[i]; v[i] = keep + __shfl_xor(send, (BIT)); } }
    WR_STEP(16, 32) WR_STEP(8, 16) WR_STEP(4, 8) WR_STEP(2, 4) WR_STEP(1, 2)
#undef WR_STEP
    return v[0] + __shfl_xor(v[0], 1);
}
typedef float f32x2 __attribute__((ext_vector_type(2)));
constexpr int CR = 8, CWIN = CR + CW - 1;
template <int SKIP> __device__ __forceinline__ void conv_fma(const unsigned (&xr)[CWIN], const f32x2 (&w)[CW], f32x2 (&acc)[CR]) {
#pragma unroll
    for (int i = SKIP; i < CWIN; ++i) {
        const f32x2 xv = {bflo(xr[i]), bfhi(xr[i])};
#pragma unroll
        for (int r = 0; r < CR; ++r) { const int j = i - r; if (j >= 0 && j < CW) acc[r] += xv * w[j]; }
    }
}
__device__ __forceinline__ float wave_reduce16(float (&v)[16], int lane) {
#pragma unroll
    for (int i = 0; i < 8; ++i) { const auto r = __builtin_amdgcn_permlane32_swap(__float_as_uint(v[i]), __float_as_uint(v[i + 8]), false, false); v[i] = __uint_as_float(r[0]) + __uint_as_float(r[1]); }
#pragma unroll
    for (int i = 0; i < 4; ++i) { const auto r = __builtin_amdgcn_permlane16_swap(__float_as_uint(v[i]), __float_as_uint(v[i + 4]), false, false); v[i] = __uint_as_float(r[0]) + __uint_as_float(r[1]); }
    { const bool hi = (lane & 8) != 0;
#pragma unroll
      for (int i = 0; i < 2; ++i) { const float send = hi ? v[i] : v[i + 2], keep = hi ? v[i + 2] : v[i];
          v[i] = keep + __uint_as_float(__builtin_amdgcn_update_dpp(0u, __float_as_uint(send), 0x128  , 0xf, 0xf, true)); } }
    { const bool hi = (lane & 4) != 0; const float send = hi ? v[0] : v[1], keep = hi ? v[1] : v[0];
      unsigned t = __builtin_amdgcn_update_dpp(0u, __float_as_uint(send), 0x104  , 0xf, 0x5, false);
      t = __builtin_amdgcn_update_dpp(t, __float_as_uint(send), 0x114  , 0xf, 0xa, false);
      v[0] = keep + __uint_as_float(t); }
    float t = v[0] + __uint_as_float(__builtin_amdgcn_update_dpp(0u, __float_as_uint(v[0]), 0x4E  , 0xf, 0xf, true));
    return t + __uint_as_float(__builtin_amdgcn_update_dpp(0u, __float_as_uint(t), 0xB1  , 0xf, 0xf, true));
}
template <class Seam>
__device__ __forceinline__ void conv_phase(const Frame& F, CArgs* ap, int l, const Seam& W) {
    const bf16* U = (const bf16*)(ap->ws + WS_U); bf16* V = (bf16*)(ap->ws + WS_V);
    const int ch = 128 * F.wave + 2 * F.lane;
    const float* wdw = ap->in[5] + (size_t)l * CW * D + ch;
    const f32x2 bdw = *(const f32x2*)(ap->in[6] + l * D + ch), lg = *(const f32x2*)(ap->in[7] + l * D + ch), lb = *(const f32x2*)(ap->in[8] + l * D + ch);
    LAS float* red = (LAS float*)(F.lds + RING_OFF);
    int par = 0;
    constexpr int NIT = M / 64, IPS = SEQ / 64, NCH = 64 / CR;
    const unsigned voff = (unsigned)ch * 2u;
    const int ib = F.grouped ? IPS * F.gx : 0, is = F.grouped ? F.gj : F.vcu, ist = F.grouped ? F.ng : F.G, ic = F.grouped ? IPS : NIT;
    f32x2 w[CW];
#pragma unroll
    for (int j = 0; j < CW; ++j) w[j] = *(const f32x2*)(wdw + (size_t)j * D);
    W();
    for (int il = is; il < ic; il += ist) { const int item = ib + il;
        const int sq = (item % IPS) * 64;
        const char* ub = (const char*)U + (size_t)(item / IPS) * SLAB + ((ptrdiff_t)sq - (CW - 1)) * (D * 2);
        unsigned xc[CWIN], xn[CR];
#pragma unroll
        for (int i = 0; i < CWIN; ++i) xc[i] = *(const unsigned*)(ub + (ptrdiff_t)i * (D * 2) + voff);
#pragma unroll 1
        for (int c = 0; c < NCH; ++c) {
            const int cn = c < NCH - 1 ? c + 1 : NCH - 1;
#pragma unroll
            for (int i = 0; i < CR; ++i) xn[i] = *(const unsigned*)(ub + (ptrdiff_t)(CR * cn + CW - 1 + i) * (D * 2) + voff);
            __builtin_amdgcn_sched_barrier(0);
            f32x2 acc[CR];
#pragma unroll
            for (int r = 0; r < CR; ++r) acc[r] = bdw;
            const int s0 = sq + CR * c;
            if (s0 >= 32) conv_fma<0>(xc, w, acc);
            else if (s0 == 24) conv_fma<6>(xc, w, acc);
            else if (s0 == 16) conv_fma<14>(xc, w, acc);
            else if (s0 == 8) conv_fma<22>(xc, w, acc);
            else conv_fma<30>(xc, w, acc);
            float v[2 * CR];
#pragma unroll
            for (int r = 0; r < CR; ++r) { const f32x2 cc = acc[r]; v[2 * r] = cc.x + cc.y; v[2 * r + 1] = cc.x * cc.x + cc.y * cc.y; }
            const float tot = wave_reduce16(v, F.lane);
            LAS float* redp = red + (par ? 256 : 0); par ^= 1;
            if ((F.lane & 3) == 0) redp[((F.lane >> 3) * 8 + F.wave) * 2 + ((F.lane >> 2) & 1)] = tot;
            __syncthreads();
            float mean_l, rstd_l;
            { const LAS f32x4* pr = (const LAS f32x4*)(redp + (F.lane & 7) * 16);
              const f32x4 p0 = pr[0], p1 = pr[1], p2 = pr[2], p3 = pr[3];
              mean_l = (((p0.x + p0.z) + (p1.x + p1.z)) + ((p2.x + p2.z) + (p3.x + p3.z))) * (1.0f / D);
              const float ex2 = (((p0.y + p0.w) + (p1.y + p1.w)) + ((p2.y + p2.w) + (p3.y + p3.w))) * (1.0f / D);
              rstd_l = rsqrtf(fmaxf(ex2 - mean_l * mean_l, 0.f) + LN_EPS); }
            bf16* vb = V + (size_t)(item / IPS) * (SLAB / 2) + ((size_t)sq + CR * c) * D + ch;
#pragma unroll
            for (int r = 0; r < CR; ++r) {
                const float mean = __uint_as_float(__builtin_amdgcn_readlane(__float_as_uint(mean_l), r)), rstd = __uint_as_float(__builtin_amdgcn_readlane(__float_as_uint(rstd_l), r));
                f32x2 y = (acc[r] - mean) * (lg * rstd) + lb;
#pragma unroll
                for (int i = 0; i < 2; ++i) y[i] = y[i] * __builtin_amdgcn_rcpf(1.0f + __builtin_amdgcn_exp2f(y[i] * -1.44269504089f));
                *(unsigned*)(vb + (size_t)r * D) = pk2(y.x, y.y);
            }
#pragma unroll
            for (int i = 0; i < CW - 1; ++i) xc[i] = xc[i + CR];
#pragma unroll
            for (int i = 0; i < CR; ++i) xc[CW - 1 + i] = xn[i];
        }
    }
}

constexpr int PR = 8;
template <int W> __device__ __forceinline__ void pool_item(const bf16* hb, const float* ss, bf16* P, int b, int g, int s0, int lane) {
    constexpr int NR = PR + W - 1;
    const bf16* hp = hb + (size_t)b * SEQ * D + g * GW + 4 * lane;
    v2u hr[NR];
#pragma unroll
    for (int i = 0; i < NR; ++i) { const int s = s0 - (W - 1) + i, sc = s < 0 ? 0 : s; hr[i] = *(const v2u*)(hp + (size_t)sc * D); }
    float rs;
    { const int s = s0 - (W - 1) + lane, sc = s < 0 ? 0 : (s >= SEQ ? SEQ - 1 : s); const f32x4* p = (const f32x4*)(ss + ((size_t)b * SEQ + sc) * 16);
      const f32x4 p0 = p[0], p1 = p[1], p2 = p[2], p3 = p[3];
      const float t = ((p0.x + p0.y) + (p0.z + p0.w)) + ((p1.x + p1.y) + (p1.z + p1.w)) + ((p2.x + p2.y) + (p2.z + p2.w)) + ((p3.x + p3.y) + (p3.z + p3.w));
      rs = rsqrtf(t * (1.0f / D) + pg8::RMS_EPS); }
    f32x4 hn[NR];
#pragma unroll
    for (int i = 0; i < NR; ++i) { const int s = s0 - (W - 1) + i; const float r = (s < 0) ? 0.f : __shfl(rs, i); const f32x4 hv = {bflo(hr[i].x), bfhi(hr[i].x), bflo(hr[i].y), bfhi(hr[i].y)}; hn[i] = hv * r; }
    bf16* pp = P + (size_t)b * (SLAB / 2) + ((size_t)g * SEQ + s0) * GW + 4 * lane;
#pragma unroll
    for (int r = 0; r < PR; ++r) { f32x4 sum = hn[r];
#pragma unroll
        for (int j = 1; j < W; ++j) sum += hn[r + j];
        const int s = s0 + r; const float inv = 1.0f / (float)((s + 1) < W ? (s + 1) : W);
        const f32x4 p = sum * inv - hn[r + W - 1];
        v2u o; o.x = pk2(p.x, p.y); o.y = pk2(p.z, p.w); *(v2u*)(pp + (size_t)r * GW) = o; }
}
__device__ __forceinline__ void pool_phase(const Frame& F, CArgs* ap, const float* ss) {
    const bf16* hf = (const bf16*)(ap->ws + WS_HB); bf16* P = (bf16*)(ap->ws + WS_P);
    const int gw = F.vcu * NWAVES + F.wave, NGW = F.G * NWAVES;
    constexpr int PIB = NG * (SEQ / PR);
    const int ib = F.grouped ? PIB * F.gx : 0, is = F.grouped ? F.gj * NWAVES + F.wave : gw, ist = F.grouped ? F.ng * NWAVES : NGW, ic = F.grouped ? PIB : BATCH * PIB;
    for (int il = is; il < ic; il += ist) { const int it = ib + il;
        const int g = it & 3, q = it >> 2, b = q / (SEQ / PR), s0 = (q % (SEQ / PR)) * PR;
        if (g == 0) pool_item<2>(hf, ss, P, b, 0, s0, F.lane);
        else if (g == 1) pool_item<4>(hf, ss, P, b, 1, s0, F.lane);
        else if (g == 2) pool_item<8>(hf, ss, P, b, 2, s0, F.lane);
        else pool_item<16>(hf, ss, P, b, 3, s0, F.lane);
    }
}

__device__ __forceinline__ void final_phase(const Frame& F, CArgs* ap, const float* ss) {
    const int gw = F.vcu * NWAVES + F.wave, NGW = F.G * NWAVES;
    const float* fn = ap->in[16]; float* out = ap->out; const bf16* hb = (const bf16*)(ap->ws + WS_HB);
    f32x4 gn[4];
#pragma unroll
    for (int j = 0; j < 4; ++j) gn[j] = *(const f32x4*)(fn + 4 * F.lane + 256 * j);
    const int mb = F.grouped ? SEQ * F.gx : 0, ms = F.grouped ? 2 * (F.gj * NWAVES + F.wave) : 2 * gw, mst = F.grouped ? 2 * F.ng * NWAVES : 2 * NGW, mc = F.grouped ? SEQ : M;
    for (int ml = ms; ml < mc; ml += mst) { const int m = mb + ml;
        float t = ss[(size_t)m * 16 + (F.lane & 31)];
        const GAS v2u* hr = (const GAS v2u*)(hb + (size_t)m * D) + F.lane;
        v2u raw[8];
#pragma unroll
        for (int j = 0; j < 8; ++j) raw[j] = hr[64 * j];
        t += __shfl_xor(t, 1); t += __shfl_xor(t, 2); t += __shfl_xor(t, 4); t += __shfl_xor(t, 8);
        const float rs0 = rsqrtf(__shfl(t, 0) * (1.0f / D) + pg8::RMS_EPS), rs1 = rsqrtf(__shfl(t, 16) * (1.0f / D) + pg8::RMS_EPS);
        GAS f32x4* ho = (GAS f32x4*)(out + (size_t)m * D) + F.lane;
#pragma unroll
        for (int j = 0; j < 8; ++j) { const f32x4 hv = {bflo(raw[j].x), bfhi(raw[j].x), bflo(raw[j].y), bfhi(raw[j].y)}; ho[64 * j] = hv * (j < 4 ? rs0 : rs1) * gn[j & 3]; }
    }
}

constexpr int NPH = 21;
constexpr int TAB_OFF = LDSCTL_OFF + 1024;
__global__ void __launch_bounds__(NWAVES * 64, 2) enc_fwd(Args args) {
    extern __shared__ __attribute__((aligned(16))) unsigned char lds[];
    LAS unsigned char* const ldsb = (LAS unsigned char*)lds;
    CArgs* ap = (CArgs*)__builtin_amdgcn_kernarg_segment_ptr();
    for (int u = threadIdx.x; u < (LDS_BYTES - LDSCTL_OFF) / 4; u += NWAVES * 64) ((LAS unsigned*)(ldsb + LDSCTL_OFF))[u] = 0u;
    __syncthreads();
#if !MK_PER_PHASE
    const XcdBarrier bar = xcd_barrier_post((unsigned*)(ap->ws + WS_CTL) + CW_BAR, (volatile LAS unsigned*)(ldsb + MISC_OFF) + 8);
    if (threadIdx.x == 0 && gridDim.x <= 256) __hip_atomic_store((unsigned*)(ap->ws + WS_CTL) + CW_XCC + blockIdx.x, bar.x + 1u, __ATOMIC_RELAXED, __HIP_MEMORY_SCOPE_AGENT);
    volatile LAS unsigned* const gst = (volatile LAS unsigned*)(ldsb + MISC_OFF) + 16;
#endif
    PG8_LAS float* const tab = (PG8_LAS float*)(ldsb + TAB_OFF);
    const int wave_s = __builtin_amdgcn_readfirstlane((int)threadIdx.x >> 6);
    const int ph_hi = ap->ph_hi;
    bool pend = false;
    volatile LAS unsigned* const gtg = (volatile LAS unsigned*)(ldsb + MISC_OFF) + 28;
    for (int ph = ap->ph_lo; ph < ph_hi; ++ph) {
      int nrep = 1;
      if (MK_PROBE) { const int r_ = (ph - 2) % 9; const bool mid = ph > 1 && ph < NPH - 1;
          if (((MK_PROBE & 1) && ph <= 1) || (mid && (((MK_PROBE & 2) && r_ == 0) || ((MK_PROBE & 4) && r_ == 1) || ((MK_PROBE & 8) && (r_ == 3 || r_ == 7)) || ((MK_PROBE & 16) && r_ == (MK_FUSE_POOL ? 6 : 5))))) nrep = 2; }
      for (int rep = 0; rep < nrep; ++rep) {
        asm volatile("" : "+s"(ap));
        int bid = blockIdx.x, G = gridDim.x;
        asm volatile("" : "+s"(bid), "+s"(G));
        Frame F; F.lds = ldsb; F.tid = 0; F.lane = 0; F.wave = wave_s; F.G = G;
#define MKF() do { F.lane = pg8::lane_now(); F.tid = wave_s * 64 + F.lane; } while (0)
        F.vcu = (G % 8 == 0) ? (bid % 8) * (G / 8) + bid / 8 : bid;
        F.grouped = (G == 256); F.gx = bid % 8; F.gj = bid / 8; F.ng = G / 8;
        unsigned char* const ws = ap->ws; float* const SS = (float*)(ws + WS_SS);
        volatile LAS unsigned* const wst = (volatile LAS unsigned*)(ldsb + MISC_OFF) + 20;
        if (MK_LAZY0 && F.grouped && ph >= 2) wait_weights((unsigned*)(ws + WS_CTL), (volatile LAS unsigned*)(ldsb + MISC_OFF) + 36, (unsigned)G, wave_s * 64 + pg8::lane_now() == 0, CW_W0DONE);
        if (ph >= 4) wait_weights((unsigned*)(ws + WS_CTL), wst, (unsigned)G, wave_s * 64 + pg8::lane_now() == 0);
        const int r_ph = (ph >= 2 && ph < NPH - 1) ? (ph - 2) % 9 : -1;
        const bool gemm_ph = r_ph == 0 || r_ph == 1 || r_ph == 2 || r_ph == 3 || r_ph == 4 || r_ph == 6 || r_ph == 7 || r_ph == 8;
        if (pend && !gemm_ph && !(MK_FUSE_POOL && r_ph == 5) && ph != 1) { group_wait((unsigned*)(ws + WS_CTL), F.gx, wave_s == 0 && pg8::lane_now() == 0, gtg); pend = false; }
        const SeamWait SW{(unsigned*)(ws + WS_CTL), F.gx, gtg, pend, wave_s};
        if (ph == 0) {
#ifndef NO_P0
            asm volatile("; MARK P0 begin"); MKF(); p0a_phase(F, ap); asm volatile("; MARK P0 end");
#endif
        }
        else if (ph == 1) {
#ifndef NO_P0
            MKF(); p0b_phase(F, ap);
#endif
        }
        else if (ph == NPH - 1) {
#ifndef NO_FINAL
            if (!(MK_FUSE_FINAL && F.grouped)) { asm volatile("; MARK FINAL begin"); MKF(); final_phase(F, ap, SS + (size_t)8 * M * 16); asm volatile("; MARK FINAL end"); }
#endif
        }
        else {
            const int q = ph - 2, lp = q / 9, r = q % 9, i = 2 * lp + (r >= 5 ? 1 : 0);
            bf16* const hbA = (bf16*)(ws + WS_HB); bf16* const hbB = (bf16*)((unsigned char*)ap->out + OUT_HB2);
            bf16* const hbc = (MK_FUSE_POOL && ((lp == 0 && r >= 7) || (lp == 1 && r <= 4))) ? hbB : hbA;
            const int kin = (r == 0 || r == 5) ? 2 * i : 2 * i + 1;
            if (r == 0) {
                pg8::Gemm g{hbc, (const bf16*)(ws + WS_WC1) + (size_t)lp * 2 * D * D, M, 2 * D, D, 0, (size_t)SEQ * D * 2}; pg8::StaticOrder S; S.init(M, 2 * D, G, bid);
                pg8::EpiGlu E{(bf16*)(ws + WS_U), ap->in[4] + lp * 2 * D, SS + (size_t)kin * M * 16, tab};
#ifndef NO_G1
                asm volatile("; MARK G1 begin"); pg8::gemm_phase<pg8::EpiGlu, pg8::StaticOrder, true, true, SeamWait>(F.lds + RING_OFF, g, S, E, wave_s * 64 + pg8::lane_now(), SW); asm volatile("; MARK G1 end");
#endif
            } else if (r == 1) {
#ifndef NO_CONV
                asm volatile("; MARK CONV begin"); MKF(); conv_phase(F, ap, lp, SW); asm volatile("; MARK CONV end");
#endif
            }
            else if (r == 5) { if (!MK_FUSE_POOL) {
#ifndef NO_POOL
                asm volatile("; MARK POOL begin"); MKF(); pool_phase(F, ap, SS + (size_t)kin * M * 16); asm volatile("; MARK POOL end");
#endif
            } }
            else if (r == 3 || r == 7) {
                pg8::Gemm g{hbc, (const bf16*)(ws + WS_WM1) + (size_t)i * D * FF, M, FF, D, 0, (size_t)SEQ * D * 2}; typedef std::conditional<(MK_PROBE & 64) != 0, pg8::TwiceOrder, pg8::StaticOrder>::type Ord3; Ord3 S; S.init(M, FF, G, bid);
                pg8::EpiRelu2 E{(bf16*)(ws + WS_T), FF, SS + (size_t)kin * M * 16, tab};
#ifndef NO_G3
                asm volatile("; MARK G3 begin"); pg8::gemm_phase<pg8::EpiRelu2, Ord3, true, true, SeamWait>(F.lds + RING_OFF, g, S, E, wave_s * 64 + pg8::lane_now(), SW); asm volatile("; MARK G3 end");
#endif
            } else {
                pg8::Gemm g; const float* mbias = nullptr; const float* mbscale = nullptr; int kout;
                if (r == 2) { g = pg8::Gemm{(const bf16*)(ws + WS_V), (const bf16*)(ws + WS_WC2) + (size_t)lp * D * D, M, D, D, 0, SLAB}; mbias = ap->in[10] + lp * D; kout = 2 * i + 1; }
                else if (r == 6) { g = pg8::Gemm{(const bf16*)(ws + WS_P), (const bf16*)(ws + WS_WP) + (size_t)lp * D * GW, M, D, GW, (size_t)SEQ * GW * 2, SLAB}; mbias = ap->in[12] + lp * D; mbscale = ap->in[13] + lp * D; kout = 2 * i + 1; }
                else { g = pg8::Gemm{(const bf16*)(ws + WS_T), (const bf16*)(ws + WS_WM2) + (size_t)i * D * FF, M, D, FF, 0, SLAB}; kout = 2 * i + 2; }
                typedef std::conditional<(MK_PROBE & 128) != 0, pg8::TwiceOrder, pg8::StaticOrder>::type Ord2; Ord2 S; S.init(M, D, G, bid);
                if (MK_FUSE_POOL && r == 6) {
                    pg8::StaticOrder Sp; Sp.init(M, D, G, bid);
                    bf16* const hin_ = (lp == 0) ? hbA : hbB; bf16* const hout_ = (lp == 0) ? hbB : hbA;
                    pg8::EpiRes Ep{hout_, mbias, mbscale, SS + (size_t)kout * M * 16, hin_};
                    const pg8::PoolSrc psrc{hin_, SS + (size_t)(2 * i) * M * 16};
                    pg8::pool_gemm_phase<pg8::EpiRes, pg8::StaticOrder>(F.lds + RING_OFF, (const bf16*)(ws + WS_WP) + (size_t)lp * D * GW, psrc, Sp, Ep, wave_s * 64 + pg8::lane_now(), SW);
                } else {
                if (MK_FUSE_FINAL && F.grouped && ph == NPH - 2) {
                    EpiFinal Ef{hbc, SS + (size_t)kout * M * 16, ap->in[16], ap->out, tab, bar};
                    pg8::gemm_phase<EpiFinal, Ord2, true, true, SeamWait>(F.lds + RING_OFF, g, S, Ef, wave_s * 64 + pg8::lane_now(), SW);
                } else {
                pg8::EpiRes E{hbc, mbias, mbscale, SS + (size_t)kout * M * 16, hbc};
#ifndef NO_G2
                asm volatile("; MARK G2 begin"); pg8::gemm_phase<pg8::EpiRes, Ord2, true, true, SeamWait>(F.lds + RING_OFF, g, S, E, wave_s * 64 + pg8::lane_now(), SW); asm volatile("; MARK G2 end");
#endif
                }
                }
            }
        }
        if (gemm_ph) pend = false;
#if !MK_PER_PHASE
        const int tid = wave_s * 64 + pg8::lane_now();
        if (ph + 1 < ph_hi && !(MK_FUSE_POOL && ph > 1 && ph < NPH - 1 && (ph - 2) % 9 == 5) && !(MK_FUSE_FINAL && F.grouped && ph == NPH - 2)) {
            if (ph == 1 && F.grouped) { }
            else if ((ph == 0 && !(MK_LAZY0 && F.grouped)) || !F.grouped || (MK_FUSE_POOL && ph == NPH - 2)) { xcd_barrier(bar, tid == 0); if (MK_PROBE & 32) xcd_barrier(bar, tid == 0); }
            else {
                unsigned* ctl = (unsigned*)(ap->ws + WS_CTL);
                if (ph == 0) {
                    asm volatile("s_waitcnt vmcnt(0)" ::: "memory"); __syncthreads();
                    if (tid == 0) { __builtin_amdgcn_fence(__ATOMIC_RELEASE, "agent"); asm volatile("s_waitcnt vmcnt(0)" ::: "memory"); xb_add(ctl + CW_W0DONE, 1u); } }
                if (gst[0] == 0u) {
                    if (tid == 0) { unsigned same = 1u, posted = 1u;
                        for (int k = 0; k < F.ng; ++k) { const unsigned v = xb_ld(ctl + CW_XCC + F.gx + 8 * k); posted &= (v != 0u) ? 1u : 0u; same &= (v == bar.x + 1u) ? 1u : 0u; }
                        gst[0] = posted ? (same ? 1u : 2u) : 0u; }
                    __syncthreads();
                }
                const bool same_xcd = gst[0] == 1u;
                if (MK_PROBE & 32) group_barrier(ctl, F.gx, F.ng, same_xcd, tid == 0);
                group_arrive(ctl, F.gx, F.ng, same_xcd, tid == 0, gtg); pend = true;
            }
        }
#endif
#undef MKF
      }
    }
}

extern "C" void kernel_launch(void* const* d_in, const int* in_sizes, int n_in, void* d_out, int out_size, void* d_ws, size_t ws_size, hipStream_t stream) {
    static int grid = 0;
    if (grid == 0) {
        if (n_in != 17 || in_sizes[0] != M * D || out_size != M * D || ws_size < WS_END) { fprintf(stderr, "kernel_launch: unexpected shapes (n_in %d, in0 %d, out %d, ws %zu); nothing launched\n", n_in, n_in > 0 ? in_sizes[0] : -1, out_size, ws_size); grid = -1; return; }
        int dev = 0, cus = 0, per_cu = 0;
        if (hipGetDevice(&dev) != hipSuccess || hipDeviceGetAttribute(&cus, hipDeviceAttributeMultiprocessorCount, dev) != hipSuccess) { grid = -1; return; }
        if (hipFuncSetAttribute((const void*)enc_fwd, hipFuncAttributeMaxDynamicSharedMemorySize, LDS_BYTES) != hipSuccess) { fprintf(stderr, "kernel_launch: hipFuncSetAttribute failed\n"); grid = -1; return; }
        if (hipOccupancyMaxActiveBlocksPerMultiprocessor(&per_cu, (const void*)enc_fwd, NWAVES * 64, LDS_BYTES) != hipSuccess || per_cu < 1) { fprintf(stderr, "kernel_launch: occupancy query reports %d workgroups per CU\n", per_cu); }
        (void)hipGetLastError();
        grid = cus;
    }
    if (grid < 0) return;
    (void)hipMemsetAsync((char*)d_ws + WS_CTL, 0, CTL_ZERO_BYTES, stream);
    Args a{};
    for (int i = 0; i < 17; ++i) a.in[i] = (const float*)d_in[i];
    a.out = (float*)d_out; a.ws = (unsigned char*)d_ws;
#if MK_PER_PHASE
    for (int p = 0; p < NPH; ++p) { a.ph_lo = p; a.ph_hi = p + 1; hipLaunchKernelGGL(enc_fwd, dim3(grid), dim3(NWAVES * 64), LDS_BYTES, stream, a); }
#else
    a.ph_lo = 0; a.ph_hi = NPH;
    hipLaunchKernelGGL(enc_fwd, dim3(grid), dim3(NWAVES * 64), LDS_BYTES, stream, a);
#endif
}
```
